# Optimizing an MI355X kernel written in HIP

```python
import math
import jax, jax.numpy as jnp
from jax import lax
import numpy as np

D_MODEL = 4096
BATCH = 4
SEQ = 4096
DEPTH = 2

HEAD_DIM = 128
N_HEADS_A = D_MODEL // (2 * HEAD_DIM)
N_HEADS_B = D_MODEL // (2 * HEAD_DIM)
KV_LORA = 512
N_IDX_HEADS = 32
IDX_DIM = 64
TOPK_MAX = 256
Q_CHUNK_A = 128
MOBA_BLOCK = 256
MOBA_TOPB = 3
Q_CHUNK_B = 32
MIX_WIDTH = (N_HEADS_A + N_HEADS_B) * HEAD_DIM
D_RNN = D_MODEL * 5 // 4
RG_BLOCKS = 16
RG_BW = D_RNN // RG_BLOCKS
CONV_W = 4
RG_C = 8.0
NUM_BUCKETS = 32
MAX_DISTANCE = 128
EPS = 1e-6
ATTN_SCALE = HEAD_DIM ** -0.5
IDX_SCALE = (N_IDX_HEADS ** -0.5) * (IDX_DIM ** -0.5)
N_ATTN_LAYERS = (DEPTH + 1) // 2
N_REC_LAYERS = DEPTH // 2
PROJ_A_SIZES = (N_HEADS_A * HEAD_DIM, KV_LORA, N_IDX_HEADS * IDX_DIM, IDX_DIM, N_IDX_HEADS,
                N_HEADS_B * HEAD_DIM, N_HEADS_B * HEAD_DIM, N_HEADS_B * HEAD_DIM, MIX_WIDTH)
PROJ_A_WIDTH = sum(PROJ_A_SIZES)

kernel_name = "hybrid_dsa_moba_rglru_trunk"


def rmsnorm(x, g):
    x32 = x.astype(jnp.float32)
    y = x32 * lax.rsqrt(jnp.mean(x32 * x32, axis=-1, keepdims=True) + EPS)
    return (y * g.astype(jnp.float32)).astype(x.dtype)


def layernorm(x, g, b):
    x32 = x.astype(jnp.float32)
    mu = jnp.mean(x32, axis=-1, keepdims=True)
    var = jnp.mean(jnp.square(x32 - mu), axis=-1, keepdims=True)
    y = (x32 - mu) * lax.rsqrt(var + EPS)
    return (y * g.astype(jnp.float32) + b.astype(jnp.float32)).astype(x.dtype)


def t5_bucket(dist):
    d = jnp.maximum(dist, 0)
    max_exact = NUM_BUCKETS // 2
    d_f = jnp.maximum(d, 1).astype(jnp.float32)
    large = max_exact + (jnp.log(d_f / max_exact) / math.log(MAX_DISTANCE / max_exact)
                         * (NUM_BUCKETS - max_exact)).astype(jnp.int32)
    large = jnp.minimum(large, NUM_BUCKETS - 1)
    return jnp.where(d < max_exact, d, large)


def dsa_attention(q_a, ckv, q_idx, k_idx, w_idx, bias_tab, w_uk, w_uv):
    B, S, HA, Dh = q_a.shape
    topk = min(TOPK_MAX, S // 4)
    s_pos = jnp.arange(S)
    b_idx = jnp.arange(B)[:, None, None]

    def chunk(c):
        t0 = c * Q_CHUNK_A
        t_pos = t0 + jnp.arange(Q_CHUNK_A)
        qa = lax.dynamic_slice_in_dim(q_a, t0, Q_CHUNK_A, axis=1)
        qi = lax.dynamic_slice_in_dim(q_idx, t0, Q_CHUNK_A, axis=1)
        wi = lax.dynamic_slice_in_dim(w_idx, t0, Q_CHUNK_A, axis=1)
        rel = jax.nn.relu(jnp.einsum('bthd,bsd->bths', qi, k_idx))
        score = (jnp.einsum('bths,bth->bts', rel, wi) * IDX_SCALE).astype(jnp.float32)
        causal = s_pos[None, :] <= t_pos[:, None]
        score = jnp.where(causal[None], score, -jnp.inf)
        _, idx = lax.top_k(score, topk)
        valid = idx <= t_pos[None, :, None]
        c_sel = ckv[b_idx, idx]
        q_lat = jnp.einsum('bthd,hcd->bthc', qa, w_uk)
        logits = jnp.einsum('bthc,btkc->bthk', q_lat, c_sel) * ATTN_SCALE
        bias = bias_tab[t5_bucket(t_pos[None, :, None] - idx)]
        logits = logits.astype(jnp.float32) + bias.astype(jnp.float32).transpose(0, 1, 3, 2)
        logits = jnp.where(valid[:, :, None, :], logits, -jnp.inf)
        p = jax.nn.softmax(logits, axis=-1).astype(c_sel.dtype)
        o_lat = jnp.einsum('bthk,btkc->bthc', p, c_sel)
        return jnp.einsum('bthc,hcd->bthd', o_lat, w_uv)

    out = lax.map(chunk, jnp.arange(S // Q_CHUNK_A))
    return out.transpose(1, 0, 2, 3, 4).reshape(B, S, HA, Dh)


def moba_attention(q, k, v, bias_tab):
    B, S, H, Dh = q.shape
    nb = -(-S // MOBA_BLOCK)
    pad = nb * MOBA_BLOCK - S
    kp = jnp.pad(k, ((0, 0), (0, pad), (0, 0), (0, 0)))
    vp = jnp.pad(v, ((0, 0), (0, pad), (0, 0), (0, 0)))
    kbh = kp.reshape(B, nb, MOBA_BLOCK, H, Dh).transpose(0, 3, 1, 2, 4)
    vbh = vp.reshape(B, nb, MOBA_BLOCK, H, Dh).transpose(0, 3, 1, 2, 4)
    kmean = jnp.mean(kbh, axis=3)
    topb = min(MOBA_TOPB, nb - 1)
    bi = jnp.arange(B)[:, None, None, None]
    hi = jnp.arange(H)[None, :, None, None]
    head_ids = jnp.arange(H)[None, :, None, None, None]
    blk_ids = jnp.arange(nb)

    def chunk(c):
        t0 = c * Q_CHUNK_B
        t_pos = t0 + jnp.arange(Q_CHUNK_B)
        own = t0 // MOBA_BLOCK
        qh = lax.dynamic_slice_in_dim(q, t0, Q_CHUNK_B, axis=1).transpose(0, 2, 1, 3)
        ko = lax.dynamic_slice_in_dim(kbh, own, 1, axis=2)[:, :, 0]
        vo = lax.dynamic_slice_in_dim(vbh, own, 1, axis=2)[:, :, 0]
        s_own = own * MOBA_BLOCK + jnp.arange(MOBA_BLOCK)
        b_own = bias_tab[t5_bucket(t_pos[:, None] - s_own[None, :])].transpose(2, 0, 1)
        l_own = (jnp.einsum('bhtd,bhsd->bhts', qh, ko) * ATTN_SCALE).astype(jnp.float32) \
            + b_own.astype(jnp.float32)
        l_own = jnp.where(s_own[None, :] <= t_pos[:, None], l_own, -jnp.inf)
        if topb == 0:
            p = jax.nn.softmax(l_own, axis=-1).astype(v.dtype)
            o = jnp.einsum('bhts,bhsd->bhtd', p, vo)
        else:
            gate = jnp.einsum('bhtd,bhnd->bhtn', qh, kmean).astype(jnp.float32)
            gate = jnp.where(blk_ids < own, gate, -jnp.inf)
            _, sel = lax.top_k(gate, topb)
            ksel = kbh[bi, hi, sel]
            vsel = vbh[bi, hi, sel]
            s_sel = sel[..., None] * MOBA_BLOCK + jnp.arange(MOBA_BLOCK)
            b_sel = bias_tab[t5_bucket(t_pos[None, None, :, None, None] - s_sel), head_ids]
            l_sel = (jnp.einsum('bhtd,bhtnsd->bhtns', qh, ksel) * ATTN_SCALE).astype(jnp.float32) \
                + b_sel.astype(jnp.float32)
            l_sel = jnp.where((sel < own)[..., None], l_sel, -jnp.inf)
            l_sel = l_sel.reshape(B, H, Q_CHUNK_B, topb * MOBA_BLOCK)
            p = jax.nn.softmax(jnp.concatenate([l_sel, l_own], axis=-1), axis=-1).astype(v.dtype)
            p_sel = p[..., :topb * MOBA_BLOCK]
            p_own = p[..., topb * MOBA_BLOCK:]
            o = jnp.einsum('bhtm,bhtmd->bhtd', p_sel,
                           vsel.reshape(B, H, Q_CHUNK_B, topb * MOBA_BLOCK, Dh)) \
                + jnp.einsum('bhts,bhsd->bhtd', p_own, vo)
        return o.transpose(0, 2, 1, 3)

    out = lax.map(chunk, jnp.arange(S // Q_CHUNK_B))
    return out.transpose(1, 0, 2, 3, 4).reshape(B, S, H, Dh)


def attention_layer(h, w_in, kv_g, w_uk, w_uv, idx_k_g, idx_k_b, w_out, rel_bias):
    B, S, _ = h.shape
    splits = np.cumsum(PROJ_A_SIZES)[:-1].tolist()
    proj = h @ w_in
    qa, ckv, qi, ki, wi, qb, kb, vb, z = jnp.split(proj, splits, axis=-1)
    qa = qa.reshape(B, S, N_HEADS_A, HEAD_DIM)
    ckv = rmsnorm(ckv, kv_g)
    qi = qi.reshape(B, S, N_IDX_HEADS, IDX_DIM)
    ki = layernorm(ki, idx_k_g, idx_k_b)
    oa = dsa_attention(qa, ckv, qi, ki, wi, rel_bias[:, :N_HEADS_A], w_uk, w_uv)
    ob = moba_attention(qb.reshape(B, S, N_HEADS_B, HEAD_DIM),
                        kb.reshape(B, S, N_HEADS_B, HEAD_DIM),
                        vb.reshape(B, S, N_HEADS_B, HEAD_DIM),
                        rel_bias[:, N_HEADS_A:])
    y = jnp.concatenate([oa.reshape(B, S, -1), ob.reshape(B, S, -1)], axis=-1) * jax.nn.silu(z)
    return y @ w_out


def _lin_combine(left, right):
    a1, b1 = left
    a2, b2 = right
    return a1 * a2, a2 * b1 + b2


def recurrent_layer(h, w_in, conv_w, conv_b, w_a, b_a, w_x, b_x, lam, w_out):
    B, S, _ = h.shape
    proj = h @ w_in
    xr, z = jnp.split(proj, [D_RNN], axis=-1)
    xp = jnp.pad(xr, ((0, 0), (CONV_W - 1, 0), (0, 0)))
    xc = conv_b + xp[:, 0:S] * conv_w[0]
    for j in range(1, CONV_W):
        xc = xc + xp[:, j:j + S] * conv_w[j]
    xb = xc.reshape(B, S, RG_BLOCKS, RG_BW)
    r = jax.nn.sigmoid((jnp.einsum('bsnk,nkj->bsnj', xb, w_a).reshape(B, S, D_RNN) + b_a)
                       .astype(jnp.float32))
    i = jax.nn.sigmoid((jnp.einsum('bsnk,nkj->bsnj', xb, w_x).reshape(B, S, D_RNN) + b_x)
                       .astype(jnp.float32))
    log_a = -RG_C * r * jax.nn.softplus(-lam.astype(jnp.float32))
    a = jnp.exp(log_a)
    mult = jnp.sqrt(-jnp.expm1(2.0 * log_a))
    bt = mult * (i * xc.astype(jnp.float32))
    _, hs = lax.associative_scan(_lin_combine, (a, bt), axis=1)
    y = hs.astype(h.dtype) * jax.nn.silu(z)
    return y @ w_out


def setup_inputs(seed: int = 0) -> dict:
    key = jax.random.key(seed)
    ks = jax.random.split(key, 20)
    f32 = jnp.float32
    NA, NR = N_ATTN_LAYERS, N_REC_LAYERS

    def nrm(k, shape, scale):
        return jax.random.normal(k, shape, f32) * scale

    u = jax.random.uniform(ks[18], (NR, D_RNN), f32, 0.9, 0.999)
    a0 = u ** (1.0 / RG_C)
    rec_lambda = jnp.log(a0) - jnp.log1p(-a0)
    return {
        "x": nrm(ks[0], (BATCH, SEQ, D_MODEL), 1.0),
        "norm_g": 1.0 + nrm(ks[1], (DEPTH, D_MODEL), 0.05),
        "final_g": 1.0 + nrm(ks[2], (D_MODEL,), 0.05),
        "rel_bias": nrm(ks[3], (NUM_BUCKETS, N_HEADS_A + N_HEADS_B), 0.5),
        "attn_w_in": nrm(ks[4], (NA, D_MODEL, PROJ_A_WIDTH), D_MODEL ** -0.5),
        "attn_kv_g": 1.0 + nrm(ks[5], (NA, KV_LORA), 0.05),
        "attn_w_uk": nrm(ks[6], (NA, N_HEADS_A, KV_LORA, HEAD_DIM), KV_LORA ** -0.5),
        "attn_w_uv": nrm(ks[7], (NA, N_HEADS_A, KV_LORA, HEAD_DIM), KV_LORA ** -0.5),
        "idx_k_g": 1.0 + nrm(ks[8], (NA, IDX_DIM), 0.05),
        "idx_k_b": nrm(ks[9], (NA, IDX_DIM), 0.02),
        "attn_w_out": nrm(ks[10], (NA, MIX_WIDTH, D_MODEL), MIX_WIDTH ** -0.5),
        "rec_w_in": nrm(ks[11], (NR, D_MODEL, 2 * D_RNN), D_MODEL ** -0.5),
        "rec_conv_w": nrm(ks[12], (NR, CONV_W, D_RNN), CONV_W ** -0.5),
        "rec_conv_b": nrm(ks[13], (NR, D_RNN), 0.02),
        "rec_w_a": nrm(ks[14], (NR, RG_BLOCKS, RG_BW, RG_BW), RG_BW ** -0.5),
        "rec_b_a": nrm(ks[15], (NR, D_RNN), 0.02),
        "rec_w_x": nrm(ks[16], (NR, RG_BLOCKS, RG_BW, RG_BW), RG_BW ** -0.5),
        "rec_b_x": nrm(ks[17], (NR, D_RNN), 0.02),
        "rec_lambda": rec_lambda,
        "rec_w_out": nrm(ks[19], (NR, D_RNN, D_MODEL), D_RNN ** -0.5),
    }


def reference(x, norm_g, final_g, rel_bias, attn_w_in, attn_kv_g, attn_w_uk, attn_w_uv,
              idx_k_g, idx_k_b, attn_w_out, rec_w_in, rec_conv_w, rec_conv_b, rec_w_a,
              rec_b_a, rec_w_x, rec_b_x, rec_lambda, rec_w_out):
    for layer in range(DEPTH):
        h = rmsnorm(x, norm_g[layer])
        li = layer // 2
        if layer % 2 == 0:
            x = x + attention_layer(h, attn_w_in[li], attn_kv_g[li], attn_w_uk[li], attn_w_uv[li],
                                    idx_k_g[li], idx_k_b[li], attn_w_out[li], rel_bias)
        else:
            x = x + recurrent_layer(h, rec_w_in[li], rec_conv_w[li], rec_conv_b[li], rec_w_a[li],
                                    rec_b_a[li], rec_w_x[li], rec_b_x[li], rec_lambda[li],
                                    rec_w_out[li])
    return rmsnorm(x, final_g)
```

```cpp
#include <hip/hip_runtime.h>
#include <cstdio>
#include <cstdint>
#define HK_N_LAUNCHES 15
namespace pg8 {
#define PG8_LAS __attribute__((address_space(3)))
typedef unsigned short bf16_t;
typedef short bf16x8 __attribute__((ext_vector_type(8)));
typedef float f32x4 __attribute__((ext_vector_type(4)));
typedef unsigned u32x4 __attribute__((ext_vector_type(4)));
constexpr int BM = 256, BK = 64, HALF = 128, HTB = HALF * BK * 2  , STAGE_BYTES = 8 * HTB, NXCD = 8, WGM = 8;

__host__ __device__ __forceinline__ int lds_byte(int r, int c) { const int st = (r >> 4) * 2 + (c >> 5), rr = r & 15, cc = c & 31, ob = rr * 64 + cc * 2; return st * 1024 + (ob ^ (((ob >> 9) & 1) << 5)); }
__host__ __device__ __forceinline__ void stage_rc(int b, int& R, int& C) { const int st = b / 1024, sb = b % 1024, swz = sb ^ (((sb >> 9) & 1) << 5); R = (st >> 1) * 16 + swz / 64; C = (st & 1) * 32 + (swz % 64) / 2; }
__host__ __device__ __forceinline__ int perm32(int rho) { const int n = rho >> 4, i = rho & 15; return 8 * (i >> 2) + 4 * n + (i & 3); }

struct Unit { int pm, pn; };
struct Gemm { const bf16_t* A; const bf16_t* Bt; int M, N, K; };

struct StaticOrder {
    int nM, nN, nwg, G, c;
    __host__ __device__ void init(int M, int N, int G_, int c_) { nM = M / BM; nN = N / BM; nwg = nM * nN; G = G_; c = c_; }
    __host__ __device__ bool next(int i, Unit& u) const {
        const long L = (long)i * G + c; if (L >= nwg) return false;
        int wgid = (int)L; { const int q = nwg / NXCD, r = nwg % NXCD, xcd = wgid % NXCD, off = wgid / NXCD; wgid = (xcd < r ? xcd * (q + 1) : r * (q + 1) + (xcd - r) * q) + off; }
        const int nig = WGM * nN, gid = wgid / nig, fm = gid * WGM, gsz = (nM - fm) < WGM ? (nM - fm) : WGM;
        u.pm = fm + ((wgid % nig) % gsz); u.pn = (wgid % nig) / gsz; return true;
    }
    __device__ __forceinline__ void a_ready(const Unit&) const {}
    __device__ __forceinline__ void done(const Unit&) const {}
};
struct CountedOrder : StaticOrder {
    const unsigned* ready; unsigned need; unsigned* tmo;
    __device__ __forceinline__ void a_ready(const Unit& u) const {
        if (threadIdx.x < 64) {
            const unsigned long long t0 = __builtin_amdgcn_s_memrealtime(); unsigned polls = 0;
            while ((unsigned)__builtin_amdgcn_readfirstlane(__hip_atomic_load(ready + 64 * u.pm, __ATOMIC_RELAXED, __HIP_MEMORY_SCOPE_AGENT)) < need) {
                if ((++polls & 255u) == 0u && __builtin_amdgcn_readfirstlane(__hip_atomic_load(tmo, __ATOMIC_RELAXED, __HIP_MEMORY_SCOPE_AGENT)) != 0u) break;
                if (__builtin_amdgcn_s_memrealtime() - t0 > 2000000ull) {
                    if (threadIdx.x == 0) { unsigned expect = 0u; __hip_atomic_compare_exchange_strong(tmo + 1, &expect, 0x600u | (unsigned)(u.pm & 0xff), __ATOMIC_RELAXED, __ATOMIC_RELAXED, __HIP_MEMORY_SCOPE_AGENT); __hip_atomic_store(tmo, 1u, __ATOMIC_RELAXED, __HIP_MEMORY_SCOPE_AGENT); }
                    break; }
                __builtin_amdgcn_s_sleep(2); }
            __builtin_amdgcn_fence(__ATOMIC_ACQUIRE, "agent");
            asm volatile("s_waitcnt vmcnt(0)" ::: "memory");
        }
#if !defined(BROKEN_HOOK_NO_BARRIER)
        asm volatile("" ::: "memory"); __builtin_amdgcn_s_barrier(); asm volatile("" ::: "memory");
#endif
    }
};

__device__ __forceinline__ unsigned cvt_pk_bf16(float lo, float hi) { unsigned r; asm volatile("v_cvt_pk_bf16_f32 %0, %1, %2" : "=v"(r) : "v"(lo), "v"(hi)); return r; }
typedef float f32x2 __attribute__((ext_vector_type(2)));
__device__ __forceinline__ f32x2 gelu_pk(f32x2 v) {
    const f32x2 av = __builtin_elementwise_abs(v), d = av * 0.2316418882f + 1.0f;
    f32x2 t; t.x = __builtin_amdgcn_rcpf(d.x); t.y = __builtin_amdgcn_rcpf(d.y);
    f32x2 q = t * 0.5307027145f + (-0.7265760135f); q = q * t + 0.7107068705f; q = q * t + (-0.142248368f); q = q * t + 0.127414796f; q = q * t;
    const f32x2 s = (v * v) * (-0.72134752044f);
    f32x2 e; e.x = __builtin_amdgcn_exp2f(s.x); e.y = __builtin_amdgcn_exp2f(s.y);
    const f32x2 m = v * (q * e), r = v - m;
    f32x2 o; o.x = v.x < 0.f ? m.x : r.x; o.y = v.y < 0.f ? m.y : r.y; return o;
}

struct EpiF32 {
    static constexpr bool PERM = false, AFTER_DRAIN = false;
    float* C; int ldc; const float* bias;
    __device__ __forceinline__ void operator()(const f32x4 (&acc)[2][2][4][2], const Unit& u, int wr, int wc, int fr, int fq) const {
        const int row0 = u.pm * BM + wr * 64 + fr, col0 = u.pn * BM + wc * 32 + 4 * fq;
        f32x4 bv[2][2];
#pragma unroll
        for (int bj = 0; bj < 2; ++bj)
#pragma unroll
            for (int n = 0; n < 2; ++n) bv[bj][n] = bias ? *(const f32x4*)(bias + col0 + bj * HALF + n * 16) : (f32x4){0.f, 0.f, 0.f, 0.f};
#pragma unroll
        for (int ai = 0; ai < 2; ++ai)
#pragma unroll
            for (int m = 0; m < 4; ++m) { float* rowp = C + (size_t)(row0 + ai * HALF + m * 16) * ldc + col0;
#pragma unroll
                for (int bj = 0; bj < 2; ++bj)
#pragma unroll
                    for (int n = 0; n < 2; ++n) *(f32x4*)(rowp + bj * HALF + n * 16) = acc[ai][bj][m][n] + bv[bj][n]; }
    }
};
template <int ACT  > struct EpiBf16 {
    static constexpr bool PERM = true, AFTER_DRAIN = false;
    bf16_t* O; int ldc; const float* bias; int split_cols; size_t split_stride;
    __device__ __forceinline__ void operator()(const f32x4 (&acc)[2][2][4][2], const Unit& u, int wr, int wc, int fr, int fq) const {
        const int row0 = u.pm * BM + wr * 64 + fr; int colt = u.pn * BM; bf16_t* base = O;
        if (split_cols) { const int t = colt / split_cols; base += (size_t)t * split_stride; colt -= t * split_cols; }
        const int col0 = colt + wc * 32 + 8 * fq, bcol0 = u.pn * BM + wc * 32 + 8 * fq;
        f32x4 bv[2][2];
#pragma unroll
        for (int bj = 0; bj < 2; ++bj)
#pragma unroll
            for (int n = 0; n < 2; ++n) bv[bj][n] = bias ? *(const f32x4*)(bias + bcol0 + bj * HALF + 4 * n) : (f32x4){0.f, 0.f, 0.f, 0.f};
#pragma unroll
        for (int ai = 0; ai < 2; ++ai)
#pragma unroll
            for (int m = 0; m < 4; ++m) { bf16_t* rowp = base + (size_t)(row0 + ai * HALF + m * 16) * ldc + col0;
#pragma unroll
                for (int bj = 0; bj < 2; ++bj) { f32x4 v0 = acc[ai][bj][m][0] + bv[bj][0], v1 = acc[ai][bj][m][1] + bv[bj][1];
                    if (ACT == 1) { f32x2 a = gelu_pk((f32x2){v0[0], v0[1]}), b = gelu_pk((f32x2){v0[2], v0[3]}), c = gelu_pk((f32x2){v1[0], v1[1]}), d = gelu_pk((f32x2){v1[2], v1[3]});
                        v0 = (f32x4){a.x, a.y, b.x, b.y}; v1 = (f32x4){c.x, c.y, d.x, d.y}; }
                    if (ACT == 2) {
#pragma unroll
                        for (int j = 0; j < 4; ++j) { v0[j] = 0.5f * v0[j] * (1.0f + erff(v0[j] * 0.70710678f)); v1[j] = 0.5f * v1[j] * (1.0f + erff(v1[j] * 0.70710678f)); } }
                    u32x4 w; w.x = cvt_pk_bf16(v0[0], v0[1]); w.y = cvt_pk_bf16(v0[2], v0[3]); w.z = cvt_pk_bf16(v1[0], v1[1]); w.w = cvt_pk_bf16(v1[2], v1[3]);
                    *(u32x4*)(rowp + bj * HALF) = w; } }
    }
};

template <class Epi, class Sched, bool STAMP = false>
__device__ __forceinline__ void gemm_phase(PG8_LAS unsigned char* lds, const Gemm g, const Sched& S, const Epi& E, unsigned long long* stamps) {
    const int tid = threadIdx.x, wid = __builtin_amdgcn_readfirstlane(tid >> 6), lane = tid & 63, wr = wid >> 2, wc = wid & 3, fr = lane & 15, fq = lane >> 4;
    const int K = g.K, nt = K / BK;
    int ts_lo = 0, ts_hi = 0, nts = 0; const unsigned long long rt_entry = STAMP ? (unsigned long long)wall_clock64() : 0ull;
#define PG8_STAMP() do { if (STAMP && wid == 0 && nts < 64) { const unsigned long long _c = (unsigned long long)clock64(); \
        ts_lo = (lane == nts) ? (int)(unsigned)_c : ts_lo; ts_hi = (lane == nts) ? (int)(unsigned)(_c >> 32) : ts_hi; ++nts; } } while (0)
    PG8_STAMP();
    unsigned voffA[2], voffB[2];
#pragma unroll
    for (int i = 0; i < 2; ++i) { int R, C; stage_rc(tid * 16 + i * 8192, R, C); const int Rb = Epi::PERM ? ((R & ~31) + perm32(R & 31)) : R;
        voffA[i] = (unsigned)(R * K + C) * 2u; voffB[i] = (unsigned)(Rb * K + C) * 2u; }
    const size_t kstep = (size_t)(BK * 2);
    const size_t hstep = (size_t)HALF * K * 2;
    const size_t tstep = 2 * hstep;
    const unsigned ldsw = (unsigned)wid * 1024u;
    const int aoff = lds_byte(wr * 64 + fr, fq * 8), boff = lds_byte(wc * 32 + fr, fq * 8);
#define PG8_SA(b, h) (((b) * 2 + (h)) * HTB)
#define PG8_SB(b, h) ((4 + (b) * 2 + (h)) * HTB)
#define PG8_STAGE(bufoff, gbase, voff) do { _Pragma("unroll") for (int _i = 0; _i < 2; ++_i) \
        __builtin_amdgcn_global_load_lds((const unsigned*)((const char*)(gbase) + (voff)[_i]), (PG8_LAS unsigned*)(lds + (bufoff) + ldsw + _i * 8192), 16, 0, 0); } while (0)
#define PG8_LDA(dst, b, h) do { _Pragma("unroll") for (int m = 0; m < 4; ++m) _Pragma("unroll") for (int k = 0; k < 2; ++k) dst[m][k] = *(const PG8_LAS bf16x8*)(lds + PG8_SA(b, h) + aoff + m * 2048 + k * 1024); } while (0)
#define PG8_LDB(dst, b, h) do { _Pragma("unroll") for (int n = 0; n < 2; ++n) _Pragma("unroll") for (int k = 0; k < 2; ++k) dst[n][k] = *(const PG8_LAS bf16x8*)(lds + PG8_SB(b, h) + boff + n * 2048 + k * 1024); } while (0)
#define PG8_MMA(ai, bj, At, Bt) do { __builtin_amdgcn_s_setprio(1); _Pragma("unroll") for (int m = 0; m < 4; ++m) _Pragma("unroll") for (int n = 0; n < 2; ++n) _Pragma("unroll") for (int k = 0; k < 2; ++k) \
        acc[ai][bj][m][n] = __builtin_amdgcn_mfma_f32_16x16x32_bf16(Bt[n][k], At[m][k], acc[ai][bj][m][n], 0, 0, 0); __builtin_amdgcn_s_setprio(0); } while (0)
#define PG8_WAIT_V(n) asm volatile("s_waitcnt vmcnt(" #n ")" ::: "memory")
#define PG8_WAIT_L(n) asm volatile("s_waitcnt lgkmcnt(" #n ")" ::: "memory")
#define PG8_BAR __builtin_amdgcn_s_barrier()
#define PG8_SCHED __builtin_amdgcn_sched_barrier(0)
    Unit cur, nxt; int ui = 0;
    if (!S.next(0, cur)) return;
    f32x4 acc[2][2][4][2];
#pragma unroll
    for (int a = 0; a < 2; ++a)
#pragma unroll
        for (int b = 0; b < 2; ++b)
#pragma unroll
            for (int m = 0; m < 4; ++m)
#pragma unroll
                for (int n = 0; n < 2; ++n) acc[a][b][m][n] = (f32x4){0.f, 0.f, 0.f, 0.f};
    bf16x8 At[4][2], B0[2][2], B1[2][2];
    const char* cA = (const char*)g.A + (size_t)cur.pm * tstep; const char* cB = (const char*)g.Bt + (size_t)cur.pn * tstep;
    S.a_ready(cur);
    PG8_STAGE(PG8_SB(0, 0), cB, voffB); PG8_STAGE(PG8_SA(0, 0), cA, voffA); PG8_STAGE(PG8_SB(0, 1), cB + hstep, voffB); PG8_STAGE(PG8_SA(0, 1), cA + hstep, voffA);
    if (wr == 1) PG8_BAR;
    PG8_WAIT_V(4); PG8_BAR;
    PG8_STAGE(PG8_SB(1, 0), cB + kstep, voffB); PG8_STAGE(PG8_SA(1, 0), cA + kstep, voffA); PG8_STAGE(PG8_SB(1, 1), cB + hstep + kstep, voffB);
    PG8_WAIT_V(6); PG8_BAR;
    PG8_STAMP();
    for (;;) {
        const bool has_next = S.next(ui + 1, nxt);
        const char* nA = has_next ? (const char*)g.A + (size_t)nxt.pm * tstep : cA; const char* nB = has_next ? (const char*)g.Bt + (size_t)nxt.pn * tstep : cB;
        for (int t = 0; t < nt; t += 2) {
            const bool last = (t == nt - 2);
            const char* a1 = cA + (size_t)(t + 1) * kstep;
            const char* a2 = last ? nA : cA + (size_t)(t + 2) * kstep; const char* b2 = last ? nB : cB + (size_t)(t + 2) * kstep;
            const char* a3 = a2 + kstep; const char* b3 = b2 + kstep;
            if (last && has_next) S.a_ready(nxt);
            PG8_LDB(B0, 0, 0); PG8_SCHED; PG8_LDA(At, 0, 0); PG8_STAGE(PG8_SA(1, 1), a1 + hstep, voffA);
            PG8_WAIT_L(8); PG8_BAR; PG8_WAIT_L(0); PG8_MMA(0, 0, At, B0); PG8_BAR; PG8_SCHED;
            PG8_LDB(B1, 0, 1); PG8_STAGE(PG8_SB(0, 0), b2, voffB);
            PG8_BAR; PG8_WAIT_L(0); PG8_MMA(0, 1, At, B1); PG8_BAR;
            PG8_LDA(At, 0, 1); PG8_STAGE(PG8_SA(0, 0), a2, voffA);
            PG8_BAR; PG8_WAIT_L(0); PG8_MMA(1, 0, At, B0); PG8_BAR; PG8_SCHED;
            PG8_STAGE(PG8_SB(0, 1), b2 + hstep, voffB);
            PG8_WAIT_V(6); PG8_BAR; PG8_MMA(1, 1, At, B1); PG8_BAR;
            PG8_LDB(B0, 1, 0); PG8_SCHED; PG8_LDA(At, 1, 0); PG8_STAGE(PG8_SA(0, 1), a2 + hstep, voffA);
            PG8_WAIT_L(8); PG8_BAR; PG8_WAIT_L(0); PG8_MMA(0, 0, At, B0); PG8_BAR; PG8_SCHED;
            PG8_LDB(B1, 1, 1); PG8_STAGE(PG8_SB(1, 0), b3, voffB);
            PG8_BAR; PG8_WAIT_L(0); PG8_MMA(0, 1, At, B1); PG8_BAR;
            PG8_LDA(At, 1, 1); PG8_STAGE(PG8_SA(1, 0), a3, voffA);
            PG8_BAR; PG8_WAIT_L(0); PG8_MMA(1, 0, At, B0); PG8_BAR; PG8_SCHED;
            PG8_STAGE(PG8_SB(1, 1), b3 + hstep, voffB);
            PG8_WAIT_V(6); PG8_BAR; PG8_MMA(1, 1, At, B1); PG8_BAR;
        }
        PG8_STAMP();
        if constexpr (!Epi::AFTER_DRAIN) { E(acc, cur, wr, wc, fr, fq); S.done(cur); }
        PG8_STAMP();
        if (!has_next) break;
#pragma unroll
        for (int a = 0; a < 2; ++a)
#pragma unroll
            for (int b = 0; b < 2; ++b)
#pragma unroll
                for (int m = 0; m < 4; ++m)
#pragma unroll
                    for (int n = 0; n < 2; ++n) acc[a][b][m][n] = (f32x4){0.f, 0.f, 0.f, 0.f};
        cur = nxt; cA = nA; cB = nB; ++ui;
    }
    PG8_WAIT_V(0);
    if (wr == 0) PG8_BAR;
    PG8_BAR;
    if constexpr (Epi::AFTER_DRAIN) { E.fused(acc, cur, wr, wc, fr, fq, lds, wid, lane); S.done(cur); }
    PG8_STAMP();
    if (STAMP && wid == 0) { stamps[lane] = lane < nts ? (((unsigned long long)(unsigned)ts_hi << 32) | (unsigned)ts_lo) : 0ull;
        if (lane == 62) stamps[62] = rt_entry; if (lane == 63) stamps[63] = (unsigned long long)wall_clock64(); }
#undef PG8_STAMP
#undef PG8_SA
#undef PG8_SB
#undef PG8_STAGE
#undef PG8_LDA
#undef PG8_LDB
#undef PG8_MMA
#undef PG8_WAIT_V
#undef PG8_WAIT_L
#undef PG8_BAR
#undef PG8_SCHED
}
}

#define XB_TMO      128
#define XB_XCNT(j)  (256  + 64 * (j))
#define XB_XSUB(j)  (1280 + 64 * (j))
#define XB_XGEN(j)  (2304 + 64 * (j))
#define XB_TOP      3328
#define XB_TOPGEN   3392
#define XCD_BAR_WORDS 3456
#define XB_SPIN_CAP (1u << 18)
#define LAS __attribute__((address_space(3)))

__device__ __forceinline__ unsigned xb_ld(unsigned* p)              { return __hip_atomic_load(p, __ATOMIC_RELAXED, __HIP_MEMORY_SCOPE_AGENT); }
__device__ __forceinline__ unsigned xb_add(unsigned* p, unsigned v) { return __hip_atomic_fetch_add(p, v, __ATOMIC_RELAXED, __HIP_MEMORY_SCOPE_AGENT); }
__device__ __forceinline__ unsigned xb_xcc_id() { return (unsigned)__builtin_amdgcn_s_getreg((3 << 11) | 20) & 0xFu; }
#define XB_SPIN(cond, bar) do { unsigned _sp = 0; while (cond) { __builtin_amdgcn_s_sleep(1); \
    if ((++_sp & 255u) == 0u) { if (xb_ld(&(bar)[XB_TMO])) break; if (_sp > XB_SPIN_CAP) { atomicAdd(&(bar)[XB_TMO], 1u); break; } } } } while (0)

struct XcdBarrier {
    unsigned* bar; unsigned x;
    volatile LAS unsigned* st;
};

__device__ __forceinline__ XcdBarrier xcd_barrier_post(unsigned* bar, volatile LAS unsigned* st) {
    XcdBarrier b; b.bar = bar; b.x = xb_xcc_id(); b.st = st;
    if (threadIdx.x == 0) (void)xb_add(&bar[XB_XCNT(b.x)], 1u);
    return b;
}
__device__ __forceinline__ void xcd_barrier_complete(unsigned* bar, unsigned x, unsigned& nloc, unsigned& nx) {
    const unsigned G = gridDim.x * gridDim.y * gridDim.z;
    unsigned sum, cnt, mine, sp = 0u;
    for (;;) {
        sum = 0u; cnt = 0u; mine = 0u;
#pragma unroll
        for (unsigned j = 0; j < 16; ++j) { const unsigned c = xb_ld(&bar[XB_XCNT(j)]); sum += c; cnt += (c > 0u) ? 1u : 0u; mine = (j == x) ? c : mine; }
        if (sum == G) break;
        __builtin_amdgcn_s_sleep(1);
        if ((++sp & 255u) == 0u) { if (xb_ld(&bar[XB_TMO])) break; if (sp > XB_SPIN_CAP) { atomicAdd(&bar[XB_TMO], 1u); break; } }
    }
    nloc = mine > 0u ? mine : 1u; nx = cnt > 0u ? cnt : 1u;
}

__device__ __forceinline__ void xcd_barrier(const XcdBarrier& b) {
    asm volatile("s_waitcnt vmcnt(0)" ::: "memory");
    __syncthreads();
    if (threadIdx.x == 0) {
        unsigned* bar = b.bar;
        __builtin_amdgcn_s_waitcnt(0);
        unsigned nloc = b.st[0], nx = b.st[1];
        if (nloc == 0u) { xcd_barrier_complete(bar, b.x, nloc, nx); b.st[0] = nloc; b.st[1] = nx; }
        const unsigned old = xb_add(&bar[XB_XSUB(b.x)], 1u);
        const unsigned gen = old / nloc;
        if (old + 1u == (gen + 1u) * nloc) {
            __builtin_amdgcn_fence(__ATOMIC_RELEASE, "agent");
            asm volatile("s_waitcnt vmcnt(0)" ::: "memory");
            const unsigned og = xb_add(&bar[XB_TOP], 1u);
            const unsigned tg = og / nx;
            if (og + 1u == (tg + 1u) * nx) xb_add(&bar[XB_TOPGEN], 1u);
            else XB_SPIN(xb_ld(&bar[XB_TOPGEN]) == tg, bar);
            __builtin_amdgcn_fence(__ATOMIC_ACQUIRE, "agent");
            xb_add(&bar[XB_XGEN(b.x)], 1u);
            asm volatile("s_waitcnt vmcnt(0)" ::: "memory");
        } else {
            XB_SPIN(xb_ld(&bar[XB_XGEN(b.x)]) == gen, bar);
            __builtin_amdgcn_fence(__ATOMIC_ACQUIRE, "agent");
            asm volatile("s_waitcnt vmcnt(0)" ::: "memory");
        }
    }
    __syncthreads();
}

namespace hk {
typedef unsigned short bf16_t;
typedef short bf16x8 __attribute__((ext_vector_type(8)));
typedef short bf16x4 __attribute__((ext_vector_type(4)));
typedef float f32x4 __attribute__((ext_vector_type(4)));
typedef float f32x16 __attribute__((ext_vector_type(16)));
typedef unsigned u32x4 __attribute__((ext_vector_type(4)));
typedef unsigned u32x2 __attribute__((ext_vector_type(2)));
#define HK_LAS __attribute__((address_space(3)))
#define HK_DI __device__ __forceinline__

constexpr int NTOK = 16384, DM = 4096, SEQ = 4096, NBATCH = 4;
constexpr int NP = 15104;
constexpr int QA_OFF = 0, CKV_OFF = 2048, QI_OFF = 2560, QB_OFF = 4608, KB_OFF = 6656, VB_OFF = 8704, Z_OFF = 10752, KI_OFF = 14848, WI_OFF = 14912;
constexpr int DRNN = 5120, NP2 = 10240;
constexpr int NTHREADS = 512;
constexpr int LDS_BYTES = 144 * 1024;
constexpr int LDS_MISC = 143 * 1024;
constexpr int BT_PITCH = 132;
constexpr float ATTN_SCALE = 0.08838834764831845f;
constexpr float EPS = 1e-6f;

constexpr size_t WS_CTL = 0;
constexpr size_t WS_BT = 64 * 1024;
constexpr size_t WS_LC = 96 * 1024;
constexpr size_t WS_KMEAN = 128 * 1024;
constexpr size_t WS_CARRY = 1024 * 1024;
constexpr size_t WS_RWIN_T = 8ull * 1024 * 1024;
constexpr size_t WS_RWOUT_T = WS_RWIN_T + 10240ull * 4096 * 2;
constexpr size_t WS_WG_T = WS_RWOUT_T + 4096ull * 5120 * 2;
constexpr size_t WS_L0 = WS_WG_T + 16ull * 640 * 320 * 2;
constexpr size_t WS_WIN_T = WS_L0;
constexpr size_t WS_WOUT_T = WS_WIN_T + 15104ull * 4096 * 2;
constexpr size_t WS_WUK = WS_WOUT_T + 4096ull * 4096 * 2;
constexpr size_t WS_WUVT = WS_WUK + 16ull * 512 * 128 * 2;
constexpr size_t WS_H = WS_WUVT + 16ull * 512 * 128 * 2;
constexpr size_t WS_PROJ = WS_H + 16384ull * 4096 * 2;
constexpr size_t WS_IDX = WS_PROJ + 16384ull * NP * 2;
constexpr size_t WS_CKVN = WS_IDX + 16384ull * 256 * 2;
constexpr size_t WS_KIN = WS_CKVN + 16384ull * 512 * 2;
constexpr size_t WS_WI = WS_KIN + 16384ull * 64 * 2;
constexpr size_t WS_VT = WS_WI + 16384ull * 32 * 4;
constexpr size_t WS_END0 = WS_VT + 4ull * 16 * 128 * 4096 * 2;
constexpr size_t WS_H1 = WS_L0;
constexpr size_t WS_XRZ = WS_H1 + 16384ull * 4096 * 2;
constexpr size_t WS_XC = WS_XRZ + 16384ull * NP2 * 2;
constexpr size_t WS_BB = WS_XC + 16384ull * DRNN * 2 + 4096;
constexpr size_t WS_END1 = WS_BB + 16384ull * DRNN * 2;
constexpr size_t WS_NEED = WS_END0 > WS_END1 ? WS_END0 : WS_END1;

HK_DI float bf2f(unsigned short b) { return __uint_as_float(((unsigned)b) << 16); }
HK_DI float bflo(unsigned u) { return __uint_as_float(u << 16); }
HK_DI float bfhi(unsigned u) { return __uint_as_float(u & 0xffff0000u); }
typedef __bf16 hk_bf2 __attribute__((ext_vector_type(2)));
typedef float hk_f2 __attribute__((ext_vector_type(2)));
HK_DI unsigned pk2(float lo, float hi) { const hk_f2 v = {lo, hi}; const hk_bf2 r = __builtin_convertvector(v, hk_bf2); return __builtin_bit_cast(unsigned, r); }
HK_DI unsigned short f2bf(float f) { return (unsigned short)(pk2(f, 0.f) & 0xffffu); }
HK_DI float silu_f(float v) { return v * __builtin_amdgcn_rcpf(1.0f + __expf(-v)); }
HK_DI float sigmoid_f(float v) { return __builtin_amdgcn_rcpf(1.0f + __expf(-v)); }
HK_DI float wave_sum(float v) {
#pragma unroll
    for (int o = 32; o >= 1; o >>= 1) v += __shfl_xor(v, o);
    return v;
}
HK_DI int t5_bucket(int d) {
    if (d < 16) return d;
    int b = 16;
    b += d >= 19; b += d >= 21; b += d >= 24; b += d >= 27; b += d >= 31; b += d >= 35; b += d >= 40; b += d >= 46;
    b += d >= 52; b += d >= 59; b += d >= 67; b += d >= 77; b += d >= 87; b += d >= 99; b += d >= 113;
    return b;
}

struct Args { const float* in[20]; float* out; unsigned char* ws; int ph_lo, ph_hi; };

struct EpiBf16Silu {
    static constexpr bool PERM = true, AFTER_DRAIN = false;
    bf16_t* O; int ldc; int silu_lo, silu_hi;
    __device__ __forceinline__ void operator()(const pg8::f32x4 (&acc)[2][2][4][2], const pg8::Unit& u, int wr, int wc, int fr, int fq) const {
        const int row0 = u.pm * 256 + wr * 64 + fr; const int col0 = u.pn * 256 + wc * 32 + 8 * fq;
        const bool act = (u.pn >= silu_lo) && (u.pn < silu_hi);
#pragma unroll
        for (int ai = 0; ai < 2; ++ai)
#pragma unroll
            for (int m = 0; m < 4; ++m) { bf16_t* rowp = O + (size_t)(row0 + ai * 128 + m * 16) * ldc + col0;
#pragma unroll
                for (int bj = 0; bj < 2; ++bj) { pg8::f32x4 v0 = acc[ai][bj][m][0], v1 = acc[ai][bj][m][1];
                    if (act) {
#pragma unroll
                        for (int j = 0; j < 4; ++j) { v0[j] = silu_f(v0[j]); v1[j] = silu_f(v1[j]); } }
                    u32x4 w; w.x = pk2(v0[0], v0[1]); w.y = pk2(v0[2], v0[3]); w.z = pk2(v1[0], v1[1]); w.w = pk2(v1[2], v1[3]);
                    *(u32x4*)(rowp + bj * 128) = w; } }
    }
};
struct EpiResF32 {
    static constexpr bool PERM = false, AFTER_DRAIN = false;
    const float* base; float* C; int ldc;
    __device__ __forceinline__ void operator()(const pg8::f32x4 (&acc)[2][2][4][2], const pg8::Unit& u, int wr, int wc, int fr, int fq) const {
        const int row0 = u.pm * 256 + wr * 64 + fr, col0 = u.pn * 256 + wc * 32 + 4 * fq;
#pragma unroll
        for (int ai = 0; ai < 2; ++ai)
#pragma unroll
            for (int m = 0; m < 4; ++m) { const size_t off = (size_t)(row0 + ai * 128 + m * 16) * ldc + col0;
#pragma unroll
                for (int bj = 0; bj < 2; ++bj)
#pragma unroll
                    for (int n = 0; n < 2; ++n) { const pg8::f32x4 b = *(const pg8::f32x4*)(base + off + bj * 128 + n * 16);
                        *(pg8::f32x4*)(C + off + bj * 128 + n * 16) = acc[ai][bj][m][n] + b; } }
    }
};

struct SG { const bf16_t* A; const bf16_t* Bt; int lda, ldb; size_t za, zb; int mt, nt, nz, K; };
template <class Epi>
HK_DI void sgemm_phase(HK_LAS unsigned char* lds, const SG g, const Epi& E, int vblk, int nblk) {
    HK_LAS bf16_t* As = (HK_LAS bf16_t*)lds;
    HK_LAS bf16_t* Bs = As + 128 * 72;
    const int tid = threadIdx.x, lane = tid & 63, wave = tid >> 6, wr = wave >> 2, wc = wave & 3, fr = lane & 15, fq = lane >> 4;
    const int total = g.nz * g.mt * g.nt, per_z = g.mt * g.nt;
    const int r0 = tid >> 3, ch = tid & 7;
    for (int it = vblk; it < total; it += nblk) {
        const int z = it / per_z, rem = it - z * per_z, pm = rem / g.nt, pn = rem - pm * g.nt;
        const bf16_t* Ab = g.A + z * g.za + (size_t)(pm * 128) * g.lda + 8 * ch;
        const bf16_t* Bb = g.Bt + z * g.zb + (size_t)(pn * 128) * g.ldb + 8 * ch;
        f32x4 acc[4][2];
#pragma unroll
        for (int a = 0; a < 4; ++a)
#pragma unroll
            for (int b = 0; b < 2; ++b) acc[a][b] = (f32x4){0.f, 0.f, 0.f, 0.f};
        u32x4 ra0 = *(const u32x4*)(Ab + (size_t)r0 * g.lda), ra1 = *(const u32x4*)(Ab + (size_t)(r0 + 64) * g.lda);
        u32x4 rb0 = *(const u32x4*)(Bb + (size_t)r0 * g.ldb), rb1 = *(const u32x4*)(Bb + (size_t)(r0 + 64) * g.ldb);
        for (int k0 = 0; k0 < g.K; k0 += 64) {
            __syncthreads();
            *(HK_LAS u32x4*)(As + r0 * 72 + 8 * ch) = ra0; *(HK_LAS u32x4*)(As + (r0 + 64) * 72 + 8 * ch) = ra1;
            *(HK_LAS u32x4*)(Bs + r0 * 72 + 8 * ch) = rb0; *(HK_LAS u32x4*)(Bs + (r0 + 64) * 72 + 8 * ch) = rb1;
            __syncthreads();
            if (k0 + 64 < g.K) {
                ra0 = *(const u32x4*)(Ab + (size_t)r0 * g.lda + k0 + 64); ra1 = *(const u32x4*)(Ab + (size_t)(r0 + 64) * g.lda + k0 + 64);
                rb0 = *(const u32x4*)(Bb + (size_t)r0 * g.ldb + k0 + 64); rb1 = *(const u32x4*)(Bb + (size_t)(r0 + 64) * g.ldb + k0 + 64);
            }
#pragma unroll
            for (int ks = 0; ks < 2; ++ks) {
                bf16x8 af[4], bfr[2];
#pragma unroll
                for (int mi = 0; mi < 4; ++mi) af[mi] = *(const HK_LAS bf16x8*)(As + (64 * wr + 16 * mi + fr) * 72 + 32 * ks + 8 * fq);
#pragma unroll
                for (int ni = 0; ni < 2; ++ni) bfr[ni] = *(const HK_LAS bf16x8*)(Bs + (32 * wc + 16 * ni + fr) * 72 + 32 * ks + 8 * fq);
#pragma unroll
                for (int mi = 0; mi < 4; ++mi)
#pragma unroll
                    for (int ni = 0; ni < 2; ++ni) acc[mi][ni] = __builtin_amdgcn_mfma_f32_16x16x32_bf16(bfr[ni], af[mi], acc[mi][ni], 0, 0, 0);
            }
        }
        E(z, pm, pn, wr, wc, lane, acc);
    }
    __syncthreads();
}

template <class ColMap>
HK_DI void transpose_convert(HK_LAS unsigned char* lds, const float* __restrict__ src, int ldsrc, int K, int n_tiles, ColMap cmap, bf16_t* __restrict__ dst, int vblk, int nblk) {
    HK_LAS float* sm = (HK_LAS float*)lds;
    const int tid = threadIdx.x;
    const int ktiles = K / 128, total = n_tiles * ktiles;
    for (int it = vblk; it < total; it += nblk) {
        const int kt = it / n_tiles, nt = it - kt * n_tiles;
        const int c0 = cmap(nt), k0 = kt * 128;
        if (c0 >= 0) {
            const int kr = tid >> 2, q = tid & 3;
            const float4* p = (const float4*)(src + (size_t)(k0 + kr) * ldsrc + c0 + 8 * q);
            const float4 a = p[0], b = p[1];
            HK_LAS float* d = sm + (8 * q) * 130 + kr;
            d[0] = a.x; d[130] = a.y; d[260] = a.z; d[390] = a.w; d[520] = b.x; d[650] = b.y; d[780] = b.z; d[910] = b.w;
        }
        __syncthreads();
        {
            const int kp = tid & 63, w = tid >> 6;
#pragma unroll
            for (int i = 0; i < 4; ++i) {
                const int n = w + 8 * i;
                unsigned o = 0u;
                if (c0 >= 0) { const float lo = sm[n * 130 + 2 * kp], hi = sm[n * 130 + 2 * kp + 1]; o = pk2(lo, hi); }
                *(unsigned*)(dst + (size_t)(nt * 32 + n) * K + k0 + 2 * kp) = o;
            }
        }
        __syncthreads();
    }
}

HK_DI void rmsnorm_rows_bf16(const float* __restrict__ x, const float* __restrict__ g, bf16_t* __restrict__ y, int nrows, int gwave, int nwaves, int lane) {
    for (int row = gwave; row < nrows; row += nwaves) {
        const float4* xr = (const float4*)(x + (size_t)row * DM);
        float4 v[16]; float ss = 0.f;
#pragma unroll
        for (int i = 0; i < 16; ++i) { v[i] = xr[lane + 64 * i]; ss += v[i].x * v[i].x + v[i].y * v[i].y + v[i].z * v[i].z + v[i].w * v[i].w; }
        ss = wave_sum(ss);
        const float inv = rsqrtf(ss * (1.0f / DM) + EPS);
#pragma unroll
        for (int i = 0; i < 16; ++i) { const float4 gg = ((const float4*)g)[lane + 64 * i];
            u32x2 o; o.x = pk2(v[i].x * inv * gg.x, v[i].y * inv * gg.y); o.y = pk2(v[i].z * inv * gg.z, v[i].w * inv * gg.w);
            *(u32x2*)(y + (size_t)row * DM + 4 * (lane + 64 * i)) = o; }
    }
}

struct WinMap { HK_DI int operator()(int nt) const { const int n = nt * 32; return n < 4608 ? n : (n < 14848 ? n + 96 : (n < 14944 ? n - 14848 + 4608 : -1)); } };
struct IdMap { HK_DI int operator()(int nt) const { return nt * 32; } };

HK_DI void phase0_prologue(HK_LAS unsigned char* lds, const Args& a) {
    const int tid = threadIdx.x, lane = tid & 63, wave = tid >> 6, blk = blockIdx.x, nblk = gridDim.x;
    unsigned char* ws = a.ws;
    transpose_convert(lds, a.in[4], 14944, 4096, NP / 32, WinMap(), (bf16_t*)(ws + WS_WIN_T), blk, nblk);
    transpose_convert(lds, a.in[10], 4096, 4096, 4096 / 32, IdMap(), (bf16_t*)(ws + WS_WOUT_T), blk, nblk);
    transpose_convert(lds, a.in[11], 10240, 4096, 10240 / 32, IdMap(), (bf16_t*)(ws + WS_RWIN_T), blk, nblk);
    transpose_convert(lds, a.in[19], 4096, 5120, 4096 / 32, IdMap(), (bf16_t*)(ws + WS_RWOUT_T), blk, nblk);
    for (int h = 0; h < 16; ++h)
        transpose_convert(lds, a.in[7] + (size_t)h * 512 * 128, 128, 512, 128 / 32, IdMap(), (bf16_t*)(ws + WS_WUVT) + (size_t)h * 128 * 512, blk, nblk);
    const size_t gtid = (size_t)blk * NTHREADS + tid, gstride = (size_t)nblk * NTHREADS;
    { const float4* s = (const float4*)a.in[6]; u32x2* d = (u32x2*)(ws + WS_WUK);
      for (size_t i = gtid; i < 16ull * 512 * 128 / 4; i += gstride) { const float4 v = s[i]; u32x2 o; o.x = pk2(v.x, v.y); o.y = pk2(v.z, v.w); d[i] = o; } }
    { bf16_t* d = (bf16_t*)(ws + WS_WG_T); const float* wa = a.in[14]; const float* wx = a.in[16];
      for (size_t i = gtid; i < 16ull * 640 * 320; i += gstride) { const int k = (int)(i % 320); const size_t r = i / 320; const int jp = (int)(r % 640), z = (int)(r / 640);
          const int grp = jp >> 5, ii = jp & 31; const float* w = (ii < 16) ? wa : wx; const int col = 16 * grp + (ii & 15);
          d[i] = f2bf(w[((size_t)z * 320 + k) * 320 + col]); } }
    { float* bt = (float*)(ws + WS_BT); const float* rb = a.in[3];
      for (size_t i = gtid; i < 32 * 129; i += gstride) { const int h = (int)(i / 129), d = (int)(i % 129); bt[h * BT_PITCH + d] = rb[t5_bucket(d) * 32 + h]; } }
    { float* lc = (float*)(ws + WS_LC); const float* lam = a.in[18];
      for (size_t i = gtid; i < DRNN; i += gstride) lc[i] = -8.0f * log1pf(expf(-lam[i])); }
    rmsnorm_rows_bf16(a.in[0], a.in[1], (bf16_t*)(ws + WS_H), NTOK, blk * 8 + wave, nblk * 8, lane);
}

HK_DI void phase2_post(HK_LAS unsigned char* lds, const Args& a) {
    const int tid = threadIdx.x, lane = tid & 63, wave = tid >> 6, blk = blockIdx.x, nblk = gridDim.x;
    unsigned char* ws = a.ws;
    const bf16_t* PROJ = (const bf16_t*)(ws + WS_PROJ);
    { bf16_t* CKVN = (bf16_t*)(ws + WS_CKVN); bf16_t* KIN = (bf16_t*)(ws + WS_KIN); float* WI = (float*)(ws + WS_WI);
      const float* kvg = a.in[5]; const float* kg = a.in[8]; const float* kb = a.in[9];
      for (int tok = blk * 8 + wave; tok < NTOK; tok += nblk * 8) {
          const bf16_t* pr = PROJ + (size_t)tok * NP;
          const u32x4 c = *(const u32x4*)(pr + CKV_OFF + 8 * lane);
          float v[8] = {bflo(c.x), bfhi(c.x), bflo(c.y), bfhi(c.y), bflo(c.z), bfhi(c.z), bflo(c.w), bfhi(c.w)};
          float ss = 0.f;
#pragma unroll
          for (int j = 0; j < 8; ++j) ss += v[j] * v[j];
          ss = wave_sum(ss);
          const float inv = rsqrtf(ss * (1.0f / 512.0f) + EPS);
          const float4 g0 = ((const float4*)kvg)[2 * lane], g1 = ((const float4*)kvg)[2 * lane + 1];
          u32x4 o; o.x = pk2(v[0] * inv * g0.x, v[1] * inv * g0.y); o.y = pk2(v[2] * inv * g0.z, v[3] * inv * g0.w);
          o.z = pk2(v[4] * inv * g1.x, v[5] * inv * g1.y); o.w = pk2(v[6] * inv * g1.z, v[7] * inv * g1.w);
          *(u32x4*)(CKVN + (size_t)tok * 512 + 8 * lane) = o;
          const float kv = bf2f(pr[KI_OFF + lane]);
          const float mu = wave_sum(kv) * (1.0f / 64.0f);
          const float dv = kv - mu;
          const float var = wave_sum(dv * dv) * (1.0f / 64.0f);
          KIN[(size_t)tok * 64 + lane] = f2bf(dv * rsqrtf(var + EPS) * kg[lane] + kb[lane]);
          if (lane < 32) WI[(size_t)tok * 32 + lane] = bf2f(pr[WI_OFF + lane]);
      } }
    { float* KM = (float*)(ws + WS_KMEAN);
      for (int it = blk; it < 64; it += nblk) {
          const bf16_t* base = PROJ + (size_t)(it * 256) * NP + KB_OFF + 4 * tid;
          float s0 = 0.f, s1 = 0.f, s2 = 0.f, s3 = 0.f;
          for (int r = 0; r < 256; ++r) { const u32x2 w = *(const u32x2*)(base + (size_t)r * NP); s0 += bflo(w.x); s1 += bfhi(w.x); s2 += bflo(w.y); s3 += bfhi(w.y); }
          *(float4*)(KM + (size_t)it * 2048 + 4 * tid) = make_float4(s0 * (1.0f / 256.0f), s1 * (1.0f / 256.0f), s2 * (1.0f / 256.0f), s3 * (1.0f / 256.0f));
      } }
    { bf16_t* VT = (bf16_t*)(ws + WS_VT); HK_LAS bf16_t* sm = (HK_LAS bf16_t*)lds;
      for (int it = blk; it < 4 * 16 * 64; it += nblk) {
          const int tt = it & 63, bh = it >> 6, h = bh & 15, b = bh >> 4;
          __syncthreads();
#pragma unroll
          for (int i = 0; i < 2; ++i) { const int c = tid + 512 * i, r = c >> 4, dc = c & 15;
              const u32x4 w = *(const u32x4*)(PROJ + (size_t)(b * 4096 + tt * 64 + r) * NP + VB_OFF + h * 128 + 8 * dc);
              HK_LAS bf16_t* p = sm + (8 * dc) * 72 + r;
              p[0] = (bf16_t)(w.x & 0xffff); p[72] = (bf16_t)(w.x >> 16); p[144] = (bf16_t)(w.y & 0xffff); p[216] = (bf16_t)(w.y >> 16);
              p[288] = (bf16_t)(w.z & 0xffff); p[360] = (bf16_t)(w.z >> 16); p[432] = (bf16_t)(w.w & 0xffff); p[504] = (bf16_t)(w.w >> 16); }
          __syncthreads();
#pragma unroll
          for (int i = 0; i < 2; ++i) { const int c = tid + 512 * i, d = c >> 3, tc = c & 7;
              const u32x4 w = *(const HK_LAS u32x4*)(sm + d * 72 + 8 * tc);
              *(u32x4*)(VT + ((size_t)bh * 128 + d) * 4096 + tt * 64 + 8 * tc) = w; }
      }
      __syncthreads(); }
}

HK_DI unsigned f2ord(float x) { const unsigned u = __float_as_uint(x); return (u & 0x80000000u) ? ~u : (u | 0x80000000u); }

HK_DI void phase3_indexer(const Args& a) {
    const int tid = threadIdx.x, lane = tid & 63, wave = tid >> 6;
    unsigned char* ws = a.ws;
    const bf16_t* PROJ = (const bf16_t*)(ws + WS_PROJ); const bf16_t* KIN = (const bf16_t*)(ws + WS_KIN); const float* WI = (const float*)(ws + WS_WI);
    bf16_t* IDX = (bf16_t*)(ws + WS_IDX);
    const int W = blockIdx.x * 8 + wave, NW = gridDim.x * 8;
    const int l31 = lane & 31, hf2 = lane >> 5;
    for (int q = W; q < NTOK; q += NW) {
        const int b = q >> 12, t = q & 4095;
        bf16_t* idx_out = IDX + (size_t)q * 256;
        if (t < 256) {
#pragma unroll
            for (int k = 0; k < 4; ++k) { const int s = lane + 64 * k; idx_out[s] = (bf16_t)(s <= t ? s : 0); }
            continue;
        }
        const bf16_t* qrow = PROJ + (size_t)q * NP + QI_OFF + l31 * 64 + 8 * hf2;
        bf16x8 A[4];
#pragma unroll
        for (int ks = 0; ks < 4; ++ks) A[ks] = *(const bf16x8*)(qrow + 16 * ks);
        float wv[16];
#pragma unroll
        for (int r = 0; r < 16; ++r) wv[r] = WI[(size_t)q * 32 + (r & 3) + 8 * (r >> 2) + 4 * hf2];
        const bf16_t* kbase = KIN + (size_t)(b * 4096) * 64 + (size_t)l31 * 64 + 8 * hf2;
        const int ng = (t >> 6) + 1;
        unsigned key[64];
#pragma unroll
        for (int j = 0; j < 64; ++j) {
            key[j] = 0u;
            if (j < ng) {
                float p[2];
#pragma unroll
                for (int hf = 0; hf < 2; ++hf) {
                    const bf16_t* krow = kbase + (size_t)(64 * j + 32 * hf) * 64;
                    f32x16 acc;
#pragma unroll
                    for (int r = 0; r < 16; ++r) acc[r] = 0.f;
#pragma unroll
                    for (int ks = 0; ks < 4; ++ks) acc = __builtin_amdgcn_mfma_f32_32x32x16_bf16(A[ks], *(const bf16x8*)(krow + 16 * ks), acc, 0, 0, 0);
                    float s = 0.f;
#pragma unroll
                    for (int r = 0; r < 16; ++r) s += wv[r] * fmaxf(acc[r], 0.f);
                    s += __shfl_xor(s, 32);
                    p[hf] = s;
                }
                const float v = (lane < 32) ? p[0] : p[1];
                key[j] = (64 * j + lane <= t) ? f2ord(v) : 0u;
            }
        }
        unsigned T = 0u;
        for (int bit = 31; bit >= 0; --bit) {
            const unsigned cand = T | (1u << bit);
            int cnt = 0;
#pragma unroll
            for (int j = 0; j < 64; ++j) if (j < ng) cnt += __popcll(__ballot(key[j] >= cand));
            if (cnt >= 256) { T = cand; if (cnt == 256) break; }
        }
        int base = 0;
#pragma unroll
        for (int j = 0; j < 64; ++j) if (j < ng) {
            const bool sel = key[j] > T; const unsigned long long m = __ballot(sel);
            const int pos = base + __builtin_amdgcn_mbcnt_hi((unsigned)(m >> 32), __builtin_amdgcn_mbcnt_lo((unsigned)m, 0u));
            if (sel && pos < 256) idx_out[pos] = (bf16_t)(64 * j + lane);
            base += __popcll(m);
        }
#pragma unroll
        for (int j = 0; j < 64; ++j) if (j < ng) {
            const bool sel = key[j] == T; const unsigned long long m = __ballot(sel);
            const int pos = base + __builtin_amdgcn_mbcnt_hi((unsigned)(m >> 32), __builtin_amdgcn_mbcnt_lo((unsigned)m, 0u));
            if (sel && pos < 256) idx_out[pos] = (bf16_t)(64 * j + lane);
            base += __popcll(m);
        }
    }
}

struct EpiQlat {
    bf16_t* Q;
    HK_DI void operator()(int z, int pm, int pn, int wr, int wc, int lane, const f32x4 (&acc)[4][2]) const {
        const int fr = lane & 15, fq = lane >> 4;
#pragma unroll
        for (int mi = 0; mi < 4; ++mi)
#pragma unroll
            for (int ni = 0; ni < 2; ++ni) { const int row = pm * 128 + wr * 64 + mi * 16 + fr, col = pn * 128 + wc * 32 + ni * 16 + 4 * fq;
                u32x2 o; o.x = pk2(acc[mi][ni][0], acc[mi][ni][1]); o.y = pk2(acc[mi][ni][2], acc[mi][ni][3]);
                *(u32x2*)(Q + (size_t)row * 8192 + z * 512 + col) = o; }
    }
};
struct EpiOa {
    bf16_t* Y; const bf16_t* PROJ;
    HK_DI void operator()(int z, int pm, int pn, int wr, int wc, int lane, const f32x4 (&acc)[4][2]) const {
        const int fr = lane & 15, fq = lane >> 4;
#pragma unroll
        for (int mi = 0; mi < 4; ++mi)
#pragma unroll
            for (int ni = 0; ni < 2; ++ni) { const int row = pm * 128 + wr * 64 + mi * 16 + fr, col = z * 128 + wc * 32 + ni * 16 + 4 * fq;
                const u32x2 g = *(const u32x2*)(PROJ + (size_t)row * NP + Z_OFF + col);
                u32x2 o; o.x = pk2(acc[mi][ni][0] * bflo(g.x), acc[mi][ni][1] * bfhi(g.x)); o.y = pk2(acc[mi][ni][2] * bflo(g.y), acc[mi][ni][3] * bfhi(g.y));
                *(u32x2*)(Y + (size_t)row * DM + col) = o; }
    }
};

HK_DI void phase4_dsa(HK_LAS unsigned char* lds, const Args& a) {
    const int tid = threadIdx.x, lane = tid & 63, wave = tid >> 6, fr = lane & 15, fq = lane >> 4;
    unsigned char* ws = a.ws;
    const bf16_t* CKVN = (const bf16_t*)(ws + WS_CKVN); const bf16_t* IDX = (const bf16_t*)(ws + WS_IDX); const float* BT = (const float*)(ws + WS_BT);
    bf16_t* QL = (bf16_t*)a.out;
    HK_LAS float* Pl = (HK_LAS float*)(lds + wave * 17408);
    HK_LAS bf16_t* widx = (HK_LAS bf16_t*)(lds + wave * 17408 + 16384);
    const int W = blockIdx.x * 8 + wave, NW = gridDim.x * 8;
    for (int q = W; q < NTOK; q += NW) {
        const int b = q >> 12, t = q & 4095;
        const int nsel = t < 255 ? t + 1 : 256;
        { const u32x2 w = *(const u32x2*)(IDX + (size_t)q * 256 + 4 * lane); *(HK_LAS u32x2*)(widx + 4 * lane) = w; }
        asm volatile("" ::: "memory");
        bf16x8 Bq[16];
        { const bf16_t* qp = QL + (size_t)q * 8192 + fr * 512 + 8 * fq;
#pragma unroll
          for (int ks = 0; ks < 16; ++ks) Bq[ks] = *(const bf16x8*)(qp + 32 * ks); }
        const bf16_t* cb = CKVN + (size_t)(b * 4096) * 512 + 8 * fq;
        float mx = -INFINITY;
        asm volatile("" ::: "memory");
#pragma unroll 2
        for (int kt = 0; kt < 16; ++kt) {
            const int myrow = widx[16 * kt + fr];
            const bf16_t* cr = cb + (size_t)myrow * 512;
            f32x4 acc = (f32x4){0.f, 0.f, 0.f, 0.f};
#pragma unroll
            for (int ks = 0; ks < 16; ++ks) acc = __builtin_amdgcn_mfma_f32_16x16x32_bf16(*(const bf16x8*)(cr + 32 * ks), Bq[ks], acc, 0, 0, 0);
            const u32x2 iw = *(const HK_LAS u32x2*)(widx + 16 * kt + 4 * fq);
            const int s4[4] = {(int)(iw.x & 0xffff), (int)(iw.x >> 16), (int)(iw.y & 0xffff), (int)(iw.y >> 16)};
#pragma unroll
            for (int j = 0; j < 4; ++j) {
                const int k = 16 * kt + 4 * fq + j; int d = t - s4[j]; d = d < 0 ? 0 : (d > 128 ? 128 : d);
                const float v = (k < nsel) ? acc[j] * ATTN_SCALE + BT[fr * BT_PITCH + d] : -INFINITY;
                Pl[k * 16 + fr] = v; mx = fmaxf(mx, v);
            }
        }
        mx = fmaxf(mx, __shfl_xor(mx, 16)); mx = fmaxf(mx, __shfl_xor(mx, 32));
        asm volatile("" ::: "memory");
        float sum = 0.f;
#pragma unroll 4
        for (int kt = 0; kt < 16; ++kt)
#pragma unroll
            for (int j = 0; j < 4; ++j) { const int k = 16 * kt + 4 * fq + j; const float p = __expf(Pl[k * 16 + fr] - mx); Pl[k * 16 + fr] = p; sum += p; }
        sum += __shfl_xor(sum, 16); sum += __shfl_xor(sum, 32);
        const float inv = 1.0f / sum;
        asm volatile("" ::: "memory");
        float o[16][8];
#pragma unroll
        for (int h = 0; h < 16; ++h)
#pragma unroll
            for (int e = 0; e < 8; ++e) o[h][e] = 0.f;
        const bf16_t* cb2 = CKVN + (size_t)(b * 4096) * 512 + 8 * lane;
        for (int k = 0; k < nsel; ++k) {
            const int row = widx[k];
            const u32x4 cw = *(const u32x4*)(cb2 + (size_t)row * 512);
            const float cv[8] = {bflo(cw.x), bfhi(cw.x), bflo(cw.y), bfhi(cw.y), bflo(cw.z), bfhi(cw.z), bflo(cw.w), bfhi(cw.w)};
            const HK_LAS f32x4* pp = (const HK_LAS f32x4*)(Pl + k * 16);
            const f32x4 p0 = pp[0], p1 = pp[1], p2 = pp[2], p3 = pp[3];
            const float ph[16] = {p0[0], p0[1], p0[2], p0[3], p1[0], p1[1], p1[2], p1[3], p2[0], p2[1], p2[2], p2[3], p3[0], p3[1], p3[2], p3[3]};
#pragma unroll
            for (int h = 0; h < 16; ++h)
#pragma unroll
                for (int e = 0; e < 8; ++e) o[h][e] += ph[h] * cv[e];
        }
        bf16_t* op = QL + (size_t)q * 8192 + 8 * lane;
#pragma unroll
        for (int h = 0; h < 16; ++h) { const float ih = __shfl(inv, h);
            u32x4 w; w.x = pk2(o[h][0] * ih, o[h][1] * ih); w.y = pk2(o[h][2] * ih, o[h][3] * ih); w.z = pk2(o[h][4] * ih, o[h][5] * ih); w.w = pk2(o[h][6] * ih, o[h][7] * ih);
            *(u32x4*)(op + h * 512) = w; }
        asm volatile("" ::: "memory");
    }
}

HK_DI void phase4_moba(HK_LAS unsigned char* lds, const Args& a) {
    const int tid = threadIdx.x, lane = tid & 63, wave = tid >> 6, fr = lane & 15, fq = lane >> 4;
    unsigned char* ws = a.ws;
    const bf16_t* PROJ = (const bf16_t*)(ws + WS_PROJ); const bf16_t* VT = (const bf16_t*)(ws + WS_VT); const float* KM = (const float*)(ws + WS_KMEAN);
    const float* BT = (const float*)(ws + WS_BT); bf16_t* Y = (bf16_t*)(ws + WS_H);
    HK_LAS bf16_t* Ks = (HK_LAS bf16_t*)lds;
    HK_LAS bf16_t* Vs = Ks + 64 * 136;
    HK_LAS float* gates = (HK_LAS float*)(lds + 40960);
    HK_LAS unsigned* selm = (HK_LAS unsigned*)(lds + 40960 + 8192);
    for (int it = blockIdx.x; it < 2048; it += gridDim.x) {
        const int bh = it & 63, qt = it >> 6, h = bh & 15, b = bh >> 4, own = qt >> 1, t0 = qt * 128;
        const size_t tok0 = (size_t)b * 4096 + t0;
        __syncthreads();
        { const int ql = tid >> 2, part = tid & 3;
          const bf16_t* qp = PROJ + (tok0 + ql) * NP + QB_OFF + h * 128;
          for (int n = part; n < own; n += 4) {
              const float* km = KM + ((size_t)(b * 16 + n) * 16 + h) * 128;
              float s = 0.f;
              for (int d = 0; d < 128; d += 8) { const u32x4 w = *(const u32x4*)(qp + d); const float4 k0 = *(const float4*)(km + d), k1 = *(const float4*)(km + d + 4);
                  s += bflo(w.x) * k0.x + bfhi(w.x) * k0.y + bflo(w.y) * k0.z + bfhi(w.y) * k0.w + bflo(w.z) * k1.x + bfhi(w.z) * k1.y + bflo(w.w) * k1.z + bfhi(w.w) * k1.w; }
              gates[ql * 16 + n] = s;
          }
          if (tid == 0) selm[128] = 0u; }
        __syncthreads();
        if (tid < 128) {
            unsigned m = 0u;
            for (int r = 0; r < 3 && r < own; ++r) { float best = -INFINITY; int bi = -1;
                for (int n = 0; n < own; ++n) { const float g = gates[tid * 16 + n]; if (!((m >> n) & 1u) && (bi < 0 || g > best)) { best = g; bi = n; } }
                if (bi >= 0) m |= 1u << bi; }
            selm[tid] = m; __hip_atomic_fetch_or(&selm[128], m, __ATOMIC_RELAXED, __HIP_MEMORY_SCOPE_WORKGROUP);
        }
        __syncthreads();
        const unsigned mymask = selm[16 * wave + fr], umask = selm[128];
        const int tq = t0 + 16 * wave + fr;
        bf16x8 Qf[4];
        { const bf16_t* qp = PROJ + (tok0 + 16 * wave + fr) * NP + QB_OFF + h * 128 + 8 * fq;
#pragma unroll
          for (int ks = 0; ks < 4; ++ks) Qf[ks] = *(const bf16x8*)(qp + 32 * ks); }
        f32x4 o[8];
#pragma unroll
        for (int i = 0; i < 8; ++i) o[i] = (f32x4){0.f, 0.f, 0.f, 0.f};
        float mrun = -INFINITY, lrun = 0.f;
        const float* bt = BT + (16 + h) * BT_PITCH;
        for (int n = 0; n <= own; ++n) {
            if (n < own && !((umask >> n) & 1u)) continue;
            const int nsub = (n == own) ? ((qt & 1) ? 4 : 2) : 4;
            for (int sub = 0; sub < nsub; ++sub) {
                const int s0 = 256 * n + 64 * sub;
                __syncthreads();
#pragma unroll
                for (int i = 0; i < 2; ++i) { const int c = tid + 512 * i;
                    { const int r = c >> 4, dc = c & 15;
                      *(HK_LAS u32x4*)(Ks + r * 136 + 8 * dc) = *(const u32x4*)(PROJ + ((size_t)b * 4096 + s0 + r) * NP + KB_OFF + h * 128 + 8 * dc); }
                    { const int d = c >> 3, tc = c & 7;
                      *(HK_LAS u32x4*)(Vs + d * 72 + 8 * tc) = *(const u32x4*)(VT + ((size_t)bh * 128 + d) * 4096 + s0 + 8 * tc); } }
                __syncthreads();
                float p[4][4]; float tmax = -INFINITY;
                const bool past = n < own; const bool mysel = (mymask >> n) & 1u;
#pragma unroll
                for (int mt = 0; mt < 4; ++mt) {
                    f32x4 acc = (f32x4){0.f, 0.f, 0.f, 0.f};
#pragma unroll
                    for (int ks = 0; ks < 4; ++ks) acc = __builtin_amdgcn_mfma_f32_16x16x32_bf16(*(const HK_LAS bf16x8*)(Ks + (16 * mt + fr) * 136 + 32 * ks + 8 * fq), Qf[ks], acc, 0, 0, 0);
#pragma unroll
                    for (int j = 0; j < 4; ++j) { const int s = s0 + 16 * mt + 4 * fq + j; int d = tq - s; const bool ok = past ? mysel : (d >= 0);
                        d = d < 0 ? 0 : (d > 128 ? 128 : d);
                        const float v = ok ? acc[j] * ATTN_SCALE + bt[d] : -INFINITY;
                        p[mt][j] = v; tmax = fmaxf(tmax, v); }
                }
                tmax = fmaxf(tmax, __shfl_xor(tmax, 16)); tmax = fmaxf(tmax, __shfl_xor(tmax, 32));
                const float mnew = fmaxf(mrun, tmax);
                const float msafe = (mnew == -INFINITY) ? 0.f : mnew;
                const float alpha = __expf(mrun - msafe);
                float ps = 0.f;
#pragma unroll
                for (int mt = 0; mt < 4; ++mt)
#pragma unroll
                    for (int j = 0; j < 4; ++j) { const float e = __expf(p[mt][j] - msafe); p[mt][j] = e; ps += e; }
                lrun = lrun * alpha + ps; mrun = mnew;
#pragma unroll
                for (int i = 0; i < 8; ++i) o[i] *= alpha;
#pragma unroll
                for (int kk = 0; kk < 2; ++kk) {
                    u32x4 pw; pw.x = pk2(p[2 * kk][0], p[2 * kk][1]); pw.y = pk2(p[2 * kk][2], p[2 * kk][3]); pw.z = pk2(p[2 * kk + 1][0], p[2 * kk + 1][1]); pw.w = pk2(p[2 * kk + 1][2], p[2 * kk + 1][3]);
                    const bf16x8 Pf = __builtin_bit_cast(bf16x8, pw);
#pragma unroll
                    for (int md = 0; md < 8; ++md) {
                        const HK_LAS bf16_t* vp = Vs + (16 * md + fr) * 72 + 32 * kk + 4 * fq;
                        const u32x2 v0 = *(const HK_LAS u32x2*)vp, v1 = *(const HK_LAS u32x2*)(vp + 16);
                        u32x4 vw; vw.x = v0.x; vw.y = v0.y; vw.z = v1.x; vw.w = v1.y;
                        o[md] = __builtin_amdgcn_mfma_f32_16x16x32_bf16(__builtin_bit_cast(bf16x8, vw), Pf, o[md], 0, 0, 0);
                    }
                }
            }
        }
        lrun += __shfl_xor(lrun, 16); lrun += __shfl_xor(lrun, 32);
        const float inv = 1.0f / lrun;
        { const size_t tok = tok0 + 16 * wave + fr;
#pragma unroll
          for (int md = 0; md < 8; ++md) { const int col = h * 128 + 16 * md + 4 * fq;
              const u32x2 g = *(const u32x2*)(PROJ + tok * NP + Z_OFF + 2048 + col);
              u32x2 w; w.x = pk2(o[md][0] * inv * bflo(g.x), o[md][1] * inv * bfhi(g.x)); w.y = pk2(o[md][2] * inv * bflo(g.y), o[md][3] * inv * bfhi(g.y));
              *(u32x2*)(Y + tok * DM + 2048 + col) = w; } }
    }
    __syncthreads();
}

HK_DI void phase9_conv(const Args& a) {
    unsigned char* ws = a.ws;
    const bf16_t* XRZ = (const bf16_t*)(ws + WS_XRZ); bf16_t* XC = (bf16_t*)(ws + WS_XC);
    const float* cw = a.in[12]; const float* cbias = a.in[13];
    const size_t gtid = (size_t)blockIdx.x * NTHREADS + threadIdx.x, gstride = (size_t)gridDim.x * NTHREADS;
    if (gtid < 256) ((unsigned*)(XC + (size_t)NTOK * DRNN))[gtid] = 0u;
    for (size_t i = gtid; i < (size_t)(NTOK / 16) * 640; i += gstride) {
        const int cg = (int)(i % 640), rc = (int)(i / 640), c0 = cg * 8, row0 = rc * 16, tin = row0 & 4095;
        float w[4][8], bb[8];
#pragma unroll
        for (int j = 0; j < 4; ++j) { const float4 u0 = *(const float4*)(cw + j * DRNN + c0), u1 = *(const float4*)(cw + j * DRNN + c0 + 4);
            w[j][0] = u0.x; w[j][1] = u0.y; w[j][2] = u0.z; w[j][3] = u0.w; w[j][4] = u1.x; w[j][5] = u1.y; w[j][6] = u1.z; w[j][7] = u1.w; }
        { const float4 u0 = *(const float4*)(cbias + c0), u1 = *(const float4*)(cbias + c0 + 4);
          bb[0] = u0.x; bb[1] = u0.y; bb[2] = u0.z; bb[3] = u0.w; bb[4] = u1.x; bb[5] = u1.y; bb[6] = u1.z; bb[7] = u1.w; }
        float x0[8], x1[8], x2[8];
#pragma unroll
        for (int e = 0; e < 8; ++e) { x0[e] = 0.f; x1[e] = 0.f; x2[e] = 0.f; }
        if (tin >= 3) {
            const u32x4 r0 = *(const u32x4*)(XRZ + (size_t)(row0 - 3) * NP2 + c0), r1 = *(const u32x4*)(XRZ + (size_t)(row0 - 2) * NP2 + c0), r2 = *(const u32x4*)(XRZ + (size_t)(row0 - 1) * NP2 + c0);
            x0[0] = bflo(r0.x); x0[1] = bfhi(r0.x); x0[2] = bflo(r0.y); x0[3] = bfhi(r0.y); x0[4] = bflo(r0.z); x0[5] = bfhi(r0.z); x0[6] = bflo(r0.w); x0[7] = bfhi(r0.w);
            x1[0] = bflo(r1.x); x1[1] = bfhi(r1.x); x1[2] = bflo(r1.y); x1[3] = bfhi(r1.y); x1[4] = bflo(r1.z); x1[5] = bfhi(r1.z); x1[6] = bflo(r1.w); x1[7] = bfhi(r1.w);
            x2[0] = bflo(r2.x); x2[1] = bfhi(r2.x); x2[2] = bflo(r2.y); x2[3] = bfhi(r2.y); x2[4] = bflo(r2.z); x2[5] = bfhi(r2.z); x2[6] = bflo(r2.w); x2[7] = bfhi(r2.w);
        }
#pragma unroll 4
        for (int r = 0; r < 16; ++r) {
            const u32x4 rr = *(const u32x4*)(XRZ + (size_t)(row0 + r) * NP2 + c0);
            const float x3[8] = {bflo(rr.x), bfhi(rr.x), bflo(rr.y), bfhi(rr.y), bflo(rr.z), bfhi(rr.z), bflo(rr.w), bfhi(rr.w)};
            float y[8];
#pragma unroll
            for (int e = 0; e < 8; ++e) y[e] = bb[e] + x0[e] * w[0][e] + x1[e] * w[1][e] + x2[e] * w[2][e] + x3[e] * w[3][e];
            u32x4 ow; ow.x = pk2(y[0], y[1]); ow.y = pk2(y[2], y[3]); ow.z = pk2(y[4], y[5]); ow.w = pk2(y[6], y[7]);
            *(u32x4*)(XC + (size_t)(row0 + r) * DRNN + c0) = ow;
#pragma unroll
            for (int e = 0; e < 8; ++e) { x0[e] = x1[e]; x1[e] = x2[e]; x2[e] = x3[e]; }
        }
    }
}

struct EpiGate {
    bf16_t* LA; bf16_t* BB; const bf16_t* XC; const float* ba; const float* bx; const float* LC;
    HK_DI void operator()(int z, int pm, int pn, int wr, int wc, int lane, const f32x4 (&acc)[4][2]) const {
        const int fr = lane & 15, fq = lane >> 4;
        const int c = 320 * z + 16 * (4 * pn + wc) + 4 * fq;
        const float4 va = *(const float4*)(ba + c), vx = *(const float4*)(bx + c), vl = *(const float4*)(LC + c);
        const float bav[4] = {va.x, va.y, va.z, va.w}, bxv[4] = {vx.x, vx.y, vx.z, vx.w}, lcv[4] = {vl.x, vl.y, vl.z, vl.w};
#pragma unroll
        for (int mi = 0; mi < 4; ++mi) { const int row = pm * 128 + wr * 64 + mi * 16 + fr;
            const u32x2 xw = *(const u32x2*)(XC + (size_t)row * DRNN + c);
            const float xc[4] = {bflo(xw.x), bfhi(xw.x), bflo(xw.y), bfhi(xw.y)};
            float la[4], bt[4];
#pragma unroll
            for (int j = 0; j < 4; ++j) { const float r = sigmoid_f(acc[mi][0][j] + bav[j]), ig = sigmoid_f(acc[mi][1][j] + bxv[j]);
                la[j] = r * lcv[j]; const float av = __expf(la[j]); const float m2 = fmaxf(1.0f - av * av, 0.f); bt[j] = sqrtf(m2) * ig * xc[j]; }
            u32x2 o1; o1.x = pk2(la[0], la[1]); o1.y = pk2(la[2], la[3]); *(u32x2*)(LA + (size_t)row * NP2 + c) = o1;
            u32x2 o2; o2.x = pk2(bt[0], bt[1]); o2.y = pk2(bt[2], bt[3]); *(u32x2*)(BB + (size_t)row * DRNN + c) = o2; }
    }
};

constexpr int SCAN_CH = 128, SCAN_NCH = SEQ / SCAN_CH;
template <int PASS>
HK_DI void phase_scan(const Args& a) {
    unsigned char* ws = a.ws;
    const bf16_t* LA = (const bf16_t*)(ws + WS_XRZ); const bf16_t* BB = (const bf16_t*)(ws + WS_BB); const bf16_t* SZ = (const bf16_t*)(ws + WS_XRZ) + DRNN;
    bf16_t* Y1 = (bf16_t*)(ws + WS_XC);
    float* CP = (float*)(ws + WS_CARRY); float* CH = CP + (size_t)NBATCH * SCAN_NCH * DRNN;
    const size_t gtid = (size_t)blockIdx.x * NTHREADS + threadIdx.x, gstride = (size_t)gridDim.x * NTHREADS;
    for (size_t i = gtid; i < (size_t)NBATCH * SCAN_NCH * (DRNN / 2); i += gstride) {
        const int cp = (int)(i % (DRNN / 2)), bc = (int)(i / (DRNN / 2)), ch = bc % SCAN_NCH, b = bc / SCAN_NCH, c = 2 * cp;
        const size_t row0 = (size_t)b * SEQ + (size_t)ch * SCAN_CH;
        float h0 = 0.f, h1 = 0.f, P0 = 1.f, P1 = 1.f;
        if (PASS == 2) {
            for (int k = 0; k < ch; ++k) { const float2 pp = *(const float2*)(CP + ((size_t)(b * SCAN_NCH + k)) * DRNN + c), hh = *(const float2*)(CH + ((size_t)(b * SCAN_NCH + k)) * DRNN + c);
                h0 = pp.x * h0 + hh.x; h1 = pp.y * h1 + hh.y; }
        }
#pragma unroll 8
        for (int r = 0; r < SCAN_CH; ++r) {
            const unsigned lw = *(const unsigned*)(LA + (row0 + r) * NP2 + c), bw = *(const unsigned*)(BB + (row0 + r) * DRNN + c);
            const float a0 = __expf(bflo(lw)), a1 = __expf(bfhi(lw));
            h0 = a0 * h0 + bflo(bw); h1 = a1 * h1 + bfhi(bw);
            if (PASS == 1) { P0 *= a0; P1 *= a1; }
            else { const unsigned zw = *(const unsigned*)(SZ + (row0 + r) * NP2 + c); *(unsigned*)(Y1 + (row0 + r) * DRNN + c) = pk2(h0 * bflo(zw), h1 * bfhi(zw)); }
        }
        if (PASS == 1) { *(float2*)(CP + (size_t)bc * DRNN + c) = make_float2(P0, P1); *(float2*)(CH + (size_t)bc * DRNN + c) = make_float2(h0, h1); }
    }
}

HK_DI void phase_final_norm(const Args& a) {
    const int tid = threadIdx.x, lane = tid & 63, wave = tid >> 6;
    const float* g = a.in[2];
    for (int row = blockIdx.x * 8 + wave; row < NTOK; row += gridDim.x * 8) {
        float4* xr = (float4*)(a.out + (size_t)row * DM);
        float4 v[16]; float ss = 0.f;
#pragma unroll
        for (int i = 0; i < 16; ++i) { v[i] = xr[lane + 64 * i]; ss += v[i].x * v[i].x + v[i].y * v[i].y + v[i].z * v[i].z + v[i].w * v[i].w; }
        ss = wave_sum(ss);
        const float inv = rsqrtf(ss * (1.0f / DM) + EPS);
#pragma unroll
        for (int i = 0; i < 16; ++i) { const float4 gg = ((const float4*)g)[lane + 64 * i];
            xr[lane + 64 * i] = make_float4(v[i].x * inv * gg.x, v[i].y * inv * gg.y, v[i].z * inv * gg.z, v[i].w * inv * gg.w); }
    }
}

}

#ifndef HK_N_LAUNCHES
#define HK_N_LAUNCHES 1
#endif
constexpr int HK_NPHASES = 15;

__global__ void __launch_bounds__(hk::NTHREADS, 2) hk_fwd(hk::Args args) {
    using namespace hk;
    extern __shared__ __attribute__((aligned(16))) unsigned char lds_raw[];
    HK_LAS unsigned char* lds = (HK_LAS unsigned char*)lds_raw;
    const int tid = threadIdx.x;
    unsigned char* ws = args.ws;
    if (tid < 4) ((HK_LAS unsigned*)(lds + LDS_MISC))[tid] = 0u;
    __syncthreads();
    const int lo = args.ph_lo, hi = args.ph_hi;
    XcdBarrier bar; bar.bar = (unsigned*)(ws + WS_CTL); bar.x = 0; bar.st = nullptr;
    if (hi - lo > 1) bar = xcd_barrier_post((unsigned*)(ws + WS_CTL), (volatile LAS unsigned*)(lds + LDS_MISC));
#ifndef HK_PHASE_MASK
#define HK_PHASE_MASK 0x7fff
#endif
#define HK_IN(k) (((HK_PHASE_MASK >> (k)) & 1) && lo <= (k) && (k) < hi)
#define HK_SEAM(k) do { if (HK_IN(k) && HK_IN((k) + 1)) xcd_barrier(bar); } while (0)

    if (HK_IN(0)) { phase0_prologue(lds, args); HK_SEAM(0); }
    if (HK_IN(1)) {
        pg8::Gemm g{(const pg8::bf16_t*)(ws + WS_H), (const pg8::bf16_t*)(ws + WS_WIN_T), NTOK, NP, DM};
        pg8::StaticOrder S; S.init(NTOK, NP, (int)gridDim.x, (int)blockIdx.x);
        EpiBf16Silu E{(bf16_t*)(ws + WS_PROJ), NP, Z_OFF / 256, Z_OFF / 256 + 16};
        pg8::gemm_phase<EpiBf16Silu, pg8::StaticOrder, false>(lds, g, S, E, nullptr);
        HK_SEAM(1);
    }
    if (HK_IN(2)) { phase2_post(lds, args); HK_SEAM(2); }
    if (HK_IN(3)) {
        phase3_indexer(args);
        SG g{(const bf16_t*)(ws + WS_PROJ) + QA_OFF, (const bf16_t*)(ws + WS_WUK), NP, 128, (size_t)128, (size_t)512 * 128, NTOK / 128, 512 / 128, 16, 128};
        EpiQlat E{(bf16_t*)args.out};
        sgemm_phase(lds, g, E, (int)blockIdx.x, (int)gridDim.x);
        HK_SEAM(3);
    }
    if (HK_IN(4)) { phase4_dsa(lds, args); __syncthreads(); phase4_moba(lds, args); HK_SEAM(4); }
    if (HK_IN(5)) {
        SG g{(const bf16_t*)args.out, (const bf16_t*)(ws + WS_WUVT), 8192, 512, (size_t)512, (size_t)128 * 512, NTOK / 128, 1, 16, 512};
        EpiOa E{(bf16_t*)(ws + WS_H), (const bf16_t*)(ws + WS_PROJ)};
        sgemm_phase(lds, g, E, (int)blockIdx.x, (int)gridDim.x);
        HK_SEAM(5);
    }
    if (HK_IN(6)) {
        pg8::Gemm g{(const pg8::bf16_t*)(ws + WS_H), (const pg8::bf16_t*)(ws + WS_WOUT_T), NTOK, DM, DM};
        pg8::StaticOrder S; S.init(NTOK, DM, (int)gridDim.x, (int)blockIdx.x);
        EpiResF32 E{args.in[0], args.out, DM};
        pg8::gemm_phase<EpiResF32, pg8::StaticOrder, false>(lds, g, S, E, nullptr);
        HK_SEAM(6);
    }
    if (HK_IN(7)) { rmsnorm_rows_bf16(args.out, args.in[1] + DM, (bf16_t*)(ws + WS_H1), NTOK, blockIdx.x * 8 + (tid >> 6), gridDim.x * 8, tid & 63); HK_SEAM(7); }
    if (HK_IN(8)) {
        pg8::Gemm g{(const pg8::bf16_t*)(ws + WS_H1), (const pg8::bf16_t*)(ws + WS_RWIN_T), NTOK, NP2, DM};
        pg8::StaticOrder S; S.init(NTOK, NP2, (int)gridDim.x, (int)blockIdx.x);
        EpiBf16Silu E{(bf16_t*)(ws + WS_XRZ), NP2, DRNN / 256, NP2 / 256};
        pg8::gemm_phase<EpiBf16Silu, pg8::StaticOrder, false>(lds, g, S, E, nullptr);
        HK_SEAM(8);
    }
    if (HK_IN(9)) { phase9_conv(args); HK_SEAM(9); }
    if (HK_IN(10)) {
        SG g{(const bf16_t*)(ws + WS_XC), (const bf16_t*)(ws + WS_WG_T), DRNN, 320, (size_t)320, (size_t)640 * 320, NTOK / 128, 5, 16, 320};
        EpiGate E{(bf16_t*)(ws + WS_XRZ), (bf16_t*)(ws + WS_BB), (const bf16_t*)(ws + WS_XC), args.in[15], args.in[17], (const float*)(ws + WS_LC)};
        sgemm_phase(lds, g, E, (int)blockIdx.x, (int)gridDim.x);
        HK_SEAM(10);
    }
    if (HK_IN(11)) { phase_scan<1>(args); HK_SEAM(11); }
    if (HK_IN(12)) { phase_scan<2>(args); HK_SEAM(12); }
    if (HK_IN(13)) {
        pg8::Gemm g{(const pg8::bf16_t*)(ws + WS_XC), (const pg8::bf16_t*)(ws + WS_RWOUT_T), NTOK, DM, DRNN};
        pg8::StaticOrder S; S.init(NTOK, DM, (int)gridDim.x, (int)blockIdx.x);
        EpiResF32 E{args.out, args.out, DM};
        pg8::gemm_phase<EpiResF32, pg8::StaticOrder, false>(lds, g, S, E, nullptr);
        HK_SEAM(13);
    }
    if (HK_IN(14)) { phase_final_norm(args); }
#ifdef HK_DIGEST
    if (lo == 15) {
        const size_t gt = (size_t)blockIdx.x * NTHREADS + tid, gs = (size_t)gridDim.x * NTHREADS;
        const bf16_t* PROJ = (const bf16_t*)(ws + WS_PROJ); const bf16_t* IDX = (const bf16_t*)(ws + WS_IDX); const bf16_t* CK = (const bf16_t*)(ws + WS_CKVN);
        const bf16_t* KI = (const bf16_t*)(ws + WS_KIN); const float* WIp = (const float*)(ws + WS_WI); const bf16_t* VT = (const bf16_t*)(ws + WS_VT); const float* KM = (const float*)(ws + WS_KMEAN);
        const bf16_t* Yp = (const bf16_t*)(ws + WS_H);
        for (size_t i = gt; i < (size_t)NTOK * DM; i += gs) { const int r = (int)(i >> 12), c = (int)(i & 4095); float v = 0.f;
#if HK_DIGEST == 1
            if (c < 2048) v = bf2f(PROJ[(size_t)r * NP + c * 7]);
            else if (c < 2560) v = bf2f(CK[(size_t)r * 512 + (c - 2048)]);
            else if (c < 2624) v = bf2f(KI[(size_t)r * 64 + (c - 2560)]);
            else if (c < 2656) v = WIp[(size_t)r * 32 + (c - 2624)];
            else if (c < 3072) v = bf2f(VT[((size_t)r * 4096 + c * 5) & 33554431]);
            else if (c < 3328) v = KM[((size_t)r * 32 + (c - 3072)) & 131071];
            else if (c < 3584) v = (float)IDX[(size_t)r * 256 + (c - 3328)] * (1.0f / 256.0f);
#elif HK_DIGEST == 2
            v = bf2f(Yp[i]);
#endif
            args.out[i] = v; }
    }
#endif
#undef HK_IN
#undef HK_SEAM
}

extern "C" void kernel_launch(void* const* d_in, const int* in_sizes, int n_in, void* d_out, int out_size, void* d_ws, size_t ws_size, hipStream_t stream) {
    static int grid = 0;
    if (grid == 0) {
        if (n_in != 20 || out_size != hk::NTOK * hk::DM || ws_size < hk::WS_NEED) {
            fprintf(stderr, "kernel_launch: unexpected problem (n_in %d, out %d, ws %zu, need %zu); nothing launched\n", n_in, out_size, ws_size, (size_t)hk::WS_NEED); grid = -1; return; }
        int dev = 0, cus = 0, per_cu = 0;
        if (hipGetDevice(&dev) != hipSuccess || hipDeviceGetAttribute(&cus, hipDeviceAttributeMultiprocessorCount, dev) != hipSuccess) { grid = -1; return; }
        if (hipFuncSetAttribute((const void*)hk_fwd, hipFuncAttributeMaxDynamicSharedMemorySize, hk::LDS_BYTES) != hipSuccess) { fprintf(stderr, "kernel_launch: hipFuncSetAttribute failed\n"); grid = -1; return; }
        if (hipOccupancyMaxActiveBlocksPerMultiprocessor(&per_cu, (const void*)hk_fwd, hk::NTHREADS, hk::LDS_BYTES) != hipSuccess || per_cu < 1)
            fprintf(stderr, "kernel_launch: occupancy query reports %d blocks per CU\n", per_cu);
        (void)hipGetLastError();
        grid = cus;
    }
    if (grid < 0) return;
    if (hipMemsetAsync((char*)d_ws + hk::WS_CTL, 0, 64 * 1024, stream) != hipSuccess) { fprintf(stderr, "kernel_launch: memset failed\n"); return; }
    hk::Args a{};
    for (int i = 0; i < 20; ++i) a.in[i] = (const float*)d_in[i];
    a.out = (float*)d_out; a.ws = (unsigned char*)d_ws;
#if HK_N_LAUNCHES == 1
    a.ph_lo = 0; a.ph_hi = HK_NPHASES;
    hipLaunchKernelGGL(hk_fwd, dim3(grid), dim3(hk::NTHREADS), hk::LDS_BYTES, stream, a);
#else
    for (int p = 0; p < HK_NPHASES; ++p) { a.ph_lo = p; a.ph_hi = p + 1; hipLaunchKernelGGL(hk_fwd, dim3(grid), dim3(hk::NTHREADS), hk::LDS_BYTES, stream, a); }
#ifdef HK_DIGEST
    a.ph_lo = 15; a.ph_hi = 16; hipLaunchKernelGGL(hk_fwd, dim3(grid), dim3(hk::NTHREADS), hk::LDS_BYTES, stream, a);
#endif
#endif
    const hipError_t le = hipPeekAtLastError();
    if (le != hipSuccess) fprintf(stderr, "kernel_launch: launch failed: %s\n", hipGetErrorName(le));
}
```

```cpp
#include <hip/hip_runtime.h>
#include <cstdio>
#include <cstdint>
#define HK_N_LAUNCHES 1
namespace pg8 {
#define PG8_LAS __attribute__((address_space(3)))
typedef unsigned short bf16_t;
typedef short bf16x8 __attribute__((ext_vector_type(8)));
typedef float f32x4 __attribute__((ext_vector_type(4)));
typedef unsigned u32x4 __attribute__((ext_vector_type(4)));
constexpr int BM = 256, BK = 64, HALF = 128, HTB = HALF * BK * 2  , STAGE_BYTES = 8 * HTB, NXCD = 8, WGM = 8;

__host__ __device__ __forceinline__ int lds_byte(int r, int c) { const int st = (r >> 4) * 2 + (c >> 5), rr = r & 15, cc = c & 31, ob = rr * 64 + cc * 2; return st * 1024 + (ob ^ (((ob >> 9) & 1) << 5)); }
__host__ __device__ __forceinline__ void stage_rc(int b, int& R, int& C) { const int st = b / 1024, sb = b % 1024, swz = sb ^ (((sb >> 9) & 1) << 5); R = (st >> 1) * 16 + swz / 64; C = (st & 1) * 32 + (swz % 64) / 2; }
__host__ __device__ __forceinline__ int perm32(int rho) { const int n = rho >> 4, i = rho & 15; return 8 * (i >> 2) + 4 * n + (i & 3); }

struct Unit { int pm, pn, pz; };
struct Gemm { const bf16_t* A; const bf16_t* Bt; int M, N, K; int lda, ldb; size_t za, zb; int nz; };

struct StaticOrder {
    int nM, nN, nwg, G, c, nz;
    __host__ __device__ void init(int M, int N, int G_, int c_, int nz_ = 1) { nM = M / BM; nN = N / BM; nwg = nM * nN; G = G_; c = c_; nz = nz_; }
    __host__ __device__ bool next(int i, Unit& u) const {
        const long L = (long)i * G + c; if (L >= (long)nwg * nz) return false;
        u.pz = (int)(L / nwg); int wgid = (int)(L - (long)u.pz * nwg); { const int q = nwg / NXCD, r = nwg % NXCD, xcd = wgid % NXCD, off = wgid / NXCD; wgid = (xcd < r ? xcd * (q + 1) : r * (q + 1) + (xcd - r) * q) + off; }
        const int nig = WGM * nN, gid = wgid / nig, fm = gid * WGM, gsz = (nM - fm) < WGM ? (nM - fm) : WGM;
        u.pm = fm + ((wgid % nig) % gsz); u.pn = (wgid % nig) / gsz; return true;
    }
    __device__ __forceinline__ void a_ready(const Unit&) const {}
    __device__ __forceinline__ void done(const Unit&) const {}
};
struct CountedOrder : StaticOrder {
    const unsigned* ready; unsigned need; unsigned* tmo;
    __device__ __forceinline__ void a_ready(const Unit& u) const {
        if (threadIdx.x < 64) {
            const unsigned long long t0 = __builtin_amdgcn_s_memrealtime(); unsigned polls = 0;
            while ((unsigned)__builtin_amdgcn_readfirstlane(__hip_atomic_load(ready + 64 * u.pm, __ATOMIC_RELAXED, __HIP_MEMORY_SCOPE_AGENT)) < need) {
                if ((++polls & 255u) == 0u && __builtin_amdgcn_readfirstlane(__hip_atomic_load(tmo, __ATOMIC_RELAXED, __HIP_MEMORY_SCOPE_AGENT)) != 0u) break;
                if (__builtin_amdgcn_s_memrealtime() - t0 > 2000000ull) {
                    if (threadIdx.x == 0) { unsigned expect = 0u; __hip_atomic_compare_exchange_strong(tmo + 1, &expect, 0x600u | (unsigned)(u.pm & 0xff), __ATOMIC_RELAXED, __ATOMIC_RELAXED, __HIP_MEMORY_SCOPE_AGENT); __hip_atomic_store(tmo, 1u, __ATOMIC_RELAXED, __HIP_MEMORY_SCOPE_AGENT); }
                    break; }
                __builtin_amdgcn_s_sleep(2); }
            __builtin_amdgcn_fence(__ATOMIC_ACQUIRE, "agent");
            asm volatile("s_waitcnt vmcnt(0)" ::: "memory");
        }
#if !defined(BROKEN_HOOK_NO_BARRIER)
        asm volatile("" ::: "memory"); __builtin_amdgcn_s_barrier(); asm volatile("" ::: "memory");
#endif
    }
};

__device__ __forceinline__ unsigned cvt_pk_bf16(float lo, float hi) { unsigned r; asm volatile("v_cvt_pk_bf16_f32 %0, %1, %2" : "=v"(r) : "v"(lo), "v"(hi)); return r; }
typedef float f32x2 __attribute__((ext_vector_type(2)));
__device__ __forceinline__ f32x2 gelu_pk(f32x2 v) {
    const f32x2 av = __builtin_elementwise_abs(v), d = av * 0.2316418882f + 1.0f;
    f32x2 t; t.x = __builtin_amdgcn_rcpf(d.x); t.y = __builtin_amdgcn_rcpf(d.y);
    f32x2 q = t * 0.5307027145f + (-0.7265760135f); q = q * t + 0.7107068705f; q = q * t + (-0.142248368f); q = q * t + 0.127414796f; q = q * t;
    const f32x2 s = (v * v) * (-0.72134752044f);
    f32x2 e; e.x = __builtin_amdgcn_exp2f(s.x); e.y = __builtin_amdgcn_exp2f(s.y);
    const f32x2 m = v * (q * e), r = v - m;
    f32x2 o; o.x = v.x < 0.f ? m.x : r.x; o.y = v.y < 0.f ? m.y : r.y; return o;
}

struct EpiF32 {
    static constexpr bool PERM = false, AFTER_DRAIN = false;
    float* C; int ldc; const float* bias;
    __device__ __forceinline__ void operator()(const f32x4 (&acc)[2][2][4][2], const Unit& u, int wr, int wc, int fr, int fq) const {
        const int row0 = u.pm * BM + wr * 64 + fr, col0 = u.pn * BM + wc * 32 + 4 * fq;
        f32x4 bv[2][2];
#pragma unroll
        for (int bj = 0; bj < 2; ++bj)
#pragma unroll
            for (int n = 0; n < 2; ++n) bv[bj][n] = bias ? *(const f32x4*)(bias + col0 + bj * HALF + n * 16) : (f32x4){0.f, 0.f, 0.f, 0.f};
#pragma unroll
        for (int ai = 0; ai < 2; ++ai)
#pragma unroll
            for (int m = 0; m < 4; ++m) { float* rowp = C + (size_t)(row0 + ai * HALF + m * 16) * ldc + col0;
#pragma unroll
                for (int bj = 0; bj < 2; ++bj)
#pragma unroll
                    for (int n = 0; n < 2; ++n) *(f32x4*)(rowp + bj * HALF + n * 16) = acc[ai][bj][m][n] + bv[bj][n]; }
    }
};
template <int ACT  > struct EpiBf16 {
    static constexpr bool PERM = true, AFTER_DRAIN = false;
    bf16_t* O; int ldc; const float* bias; int split_cols; size_t split_stride;
    __device__ __forceinline__ void operator()(const f32x4 (&acc)[2][2][4][2], const Unit& u, int wr, int wc, int fr, int fq) const {
        const int row0 = u.pm * BM + wr * 64 + fr; int colt = u.pn * BM; bf16_t* base = O;
        if (split_cols) { const int t = colt / split_cols; base += (size_t)t * split_stride; colt -= t * split_cols; }
        const int col0 = colt + wc * 32 + 8 * fq, bcol0 = u.pn * BM + wc * 32 + 8 * fq;
        f32x4 bv[2][2];
#pragma unroll
        for (int bj = 0; bj < 2; ++bj)
#pragma unroll
            for (int n = 0; n < 2; ++n) bv[bj][n] = bias ? *(const f32x4*)(bias + bcol0 + bj * HALF + 4 * n) : (f32x4){0.f, 0.f, 0.f, 0.f};
#pragma unroll
        for (int ai = 0; ai < 2; ++ai)
#pragma unroll
            for (int m = 0; m < 4; ++m) { bf16_t* rowp = base + (size_t)(row0 + ai * HALF + m * 16) * ldc + col0;
#pragma unroll
                for (int bj = 0; bj < 2; ++bj) { f32x4 v0 = acc[ai][bj][m][0] + bv[bj][0], v1 = acc[ai][bj][m][1] + bv[bj][1];
                    if (ACT == 1) { f32x2 a = gelu_pk((f32x2){v0[0], v0[1]}), b = gelu_pk((f32x2){v0[2], v0[3]}), c = gelu_pk((f32x2){v1[0], v1[1]}), d = gelu_pk((f32x2){v1[2], v1[3]});
                        v0 = (f32x4){a.x, a.y, b.x, b.y}; v1 = (f32x4){c.x, c.y, d.x, d.y}; }
                    if (ACT == 2) {
#pragma unroll
                        for (int j = 0; j < 4; ++j) { v0[j] = 0.5f * v0[j] * (1.0f + erff(v0[j] * 0.70710678f)); v1[j] = 0.5f * v1[j] * (1.0f + erff(v1[j] * 0.70710678f)); } }
                    u32x4 w; w.x = cvt_pk_bf16(v0[0], v0[1]); w.y = cvt_pk_bf16(v0[2], v0[3]); w.z = cvt_pk_bf16(v1[0], v1[1]); w.w = cvt_pk_bf16(v1[2], v1[3]);
                    *(u32x4*)(rowp + bj * HALF) = w; } }
    }
};

template <class Epi, class Sched, bool STAMP = false>
__device__ __forceinline__ void gemm_phase(PG8_LAS unsigned char* lds, const Gemm g, const Sched& S, const Epi& E, unsigned long long* stamps) {
    const int tid = threadIdx.x, wid = __builtin_amdgcn_readfirstlane(tid >> 6), lane = tid & 63, wr = wid >> 2, wc = wid & 3, fr = lane & 15, fq = lane >> 4;
    const int K = g.K, nt = K / BK;
    int ts_lo = 0, ts_hi = 0, nts = 0; const unsigned long long rt_entry = STAMP ? (unsigned long long)wall_clock64() : 0ull;
#define PG8_STAMP() do { if (STAMP && wid == 0 && nts < 64) { const unsigned long long _c = (unsigned long long)clock64(); \
        ts_lo = (lane == nts) ? (int)(unsigned)_c : ts_lo; ts_hi = (lane == nts) ? (int)(unsigned)(_c >> 32) : ts_hi; ++nts; } } while (0)
    PG8_STAMP();
    unsigned voffA[2], voffB[2];
#pragma unroll
    for (int i = 0; i < 2; ++i) { int R, C; stage_rc(tid * 16 + i * 8192, R, C); const int Rb = Epi::PERM ? ((R & ~31) + perm32(R & 31)) : R;
        voffA[i] = (unsigned)(R * g.lda + C) * 2u; voffB[i] = (unsigned)(Rb * g.ldb + C) * 2u; }
    const size_t kstep = (size_t)(BK * 2);
    const size_t hstepA = (size_t)HALF * g.lda * 2, hstepB = (size_t)HALF * g.ldb * 2;
    const size_t tstepA = 2 * hstepA, tstepB = 2 * hstepB;
    const unsigned ldsw = (unsigned)wid * 1024u;
    const int aoff = lds_byte(wr * 64 + fr, fq * 8), boff = lds_byte(wc * 32 + fr, fq * 8);
#define PG8_SA(b, h) (((b) * 2 + (h)) * HTB)
#define PG8_SB(b, h) ((4 + (b) * 2 + (h)) * HTB)
#define PG8_STAGE(bufoff, gbase, voff) do { _Pragma("unroll") for (int _i = 0; _i < 2; ++_i) \
        __builtin_amdgcn_global_load_lds((const unsigned*)((const char*)(gbase) + (voff)[_i]), (PG8_LAS unsigned*)(lds + (bufoff) + ldsw + _i * 8192), 16, 0, 0); } while (0)
#define PG8_LDA(dst, b, h) do { _Pragma("unroll") for (int m = 0; m < 4; ++m) _Pragma("unroll") for (int k = 0; k < 2; ++k) dst[m][k] = *(const PG8_LAS bf16x8*)(lds + PG8_SA(b, h) + aoff + m * 2048 + k * 1024); } while (0)
#define PG8_LDB(dst, b, h) do { _Pragma("unroll") for (int n = 0; n < 2; ++n) _Pragma("unroll") for (int k = 0; k < 2; ++k) dst[n][k] = *(const PG8_LAS bf16x8*)(lds + PG8_SB(b, h) + boff + n * 2048 + k * 1024); } while (0)
#define PG8_MMA(ai, bj, At, Bt) do { __builtin_amdgcn_s_setprio(1); _Pragma("unroll") for (int m = 0; m < 4; ++m) _Pragma("unroll") for (int n = 0; n < 2; ++n) _Pragma("unroll") for (int k = 0; k < 2; ++k) \
        acc[ai][bj][m][n] = __builtin_amdgcn_mfma_f32_16x16x32_bf16(Bt[n][k], At[m][k], acc[ai][bj][m][n], 0, 0, 0); __builtin_amdgcn_s_setprio(0); } while (0)
#define PG8_WAIT_V(n) asm volatile("s_waitcnt vmcnt(" #n ")" ::: "memory")
#define PG8_WAIT_L(n) asm volatile("s_waitcnt lgkmcnt(" #n ")" ::: "memory")
#define PG8_BAR __builtin_amdgcn_s_barrier()
#define PG8_SCHED __builtin_amdgcn_sched_barrier(0)
    Unit cur, nxt; int ui = 0;
    if (!S.next(0, cur)) return;
    f32x4 acc[2][2][4][2];
#pragma unroll
    for (int a = 0; a < 2; ++a)
#pragma unroll
        for (int b = 0; b < 2; ++b)
#pragma unroll
            for (int m = 0; m < 4; ++m)
#pragma unroll
                for (int n = 0; n < 2; ++n) acc[a][b][m][n] = (f32x4){0.f, 0.f, 0.f, 0.f};
    bf16x8 At[4][2], B0[2][2], B1[2][2];
    const char* cA = (const char*)(g.A + (size_t)cur.pz * g.za) + (size_t)cur.pm * tstepA; const char* cB = (const char*)(g.Bt + (size_t)cur.pz * g.zb) + (size_t)cur.pn * tstepB;
    S.a_ready(cur);
    PG8_STAGE(PG8_SB(0, 0), cB, voffB); PG8_STAGE(PG8_SA(0, 0), cA, voffA); PG8_STAGE(PG8_SB(0, 1), cB + hstepB, voffB); PG8_STAGE(PG8_SA(0, 1), cA + hstepA, voffA);
    if (wr == 1) PG8_BAR;
    PG8_WAIT_V(4); PG8_BAR;
    PG8_STAGE(PG8_SB(1, 0), cB + kstep, voffB); PG8_STAGE(PG8_SA(1, 0), cA + kstep, voffA); PG8_STAGE(PG8_SB(1, 1), cB + hstepB + kstep, voffB);
    PG8_WAIT_V(6); PG8_BAR;
    PG8_STAMP();
    for (;;) {
        const bool has_next = S.next(ui + 1, nxt);
        const char* nA = has_next ? (const char*)(g.A + (size_t)nxt.pz * g.za) + (size_t)nxt.pm * tstepA : cA; const char* nB = has_next ? (const char*)(g.Bt + (size_t)nxt.pz * g.zb) + (size_t)nxt.pn * tstepB : cB;
        for (int t = 0; t < nt; t += 2) {
            const bool last = (t == nt - 2);
            const char* a1 = cA + (size_t)(t + 1) * kstep;
            const char* a2 = last ? nA : cA + (size_t)(t + 2) * kstep; const char* b2 = last ? nB : cB + (size_t)(t + 2) * kstep;
            const char* a3 = a2 + kstep; const char* b3 = b2 + kstep;
            if (last && has_next) S.a_ready(nxt);
            PG8_LDB(B0, 0, 0); PG8_SCHED; PG8_LDA(At, 0, 0); PG8_STAGE(PG8_SA(1, 1), a1 + hstepA, voffA);
            PG8_WAIT_L(8); PG8_BAR; PG8_WAIT_L(0); PG8_MMA(0, 0, At, B0); PG8_BAR; PG8_SCHED;
            PG8_LDB(B1, 0, 1); PG8_STAGE(PG8_SB(0, 0), b2, voffB);
            PG8_BAR; PG8_WAIT_L(0); PG8_MMA(0, 1, At, B1); PG8_BAR;
            PG8_LDA(At, 0, 1); PG8_STAGE(PG8_SA(0, 0), a2, voffA);
            PG8_BAR; PG8_WAIT_L(0); PG8_MMA(1, 0, At, B0); PG8_BAR; PG8_SCHED;
            PG8_STAGE(PG8_SB(0, 1), b2 + hstepB, voffB);
            PG8_WAIT_V(6); PG8_BAR; PG8_MMA(1, 1, At, B1); PG8_BAR;
            PG8_LDB(B0, 1, 0); PG8_SCHED; PG8_LDA(At, 1, 0); PG8_STAGE(PG8_SA(0, 1), a2 + hstepA, voffA);
            PG8_WAIT_L(8); PG8_BAR; PG8_WAIT_L(0); PG8_MMA(0, 0, At, B0); PG8_BAR; PG8_SCHED;
            PG8_LDB(B1, 1, 1); PG8_STAGE(PG8_SB(1, 0), b3, voffB);
            PG8_BAR; PG8_WAIT_L(0); PG8_MMA(0, 1, At, B1); PG8_BAR;
            PG8_LDA(At, 1, 1); PG8_STAGE(PG8_SA(1, 0), a3, voffA);
            PG8_BAR; PG8_WAIT_L(0); PG8_MMA(1, 0, At, B0); PG8_BAR; PG8_SCHED;
            PG8_STAGE(PG8_SB(1, 1), b3 + hstepB, voffB);
            PG8_WAIT_V(6); PG8_BAR; PG8_MMA(1, 1, At, B1); PG8_BAR;
        }
        PG8_STAMP();
        if constexpr (!Epi::AFTER_DRAIN) { E(acc, cur, wr, wc, fr, fq); S.done(cur); }
        PG8_STAMP();
        if (!has_next) break;
#pragma unroll
        for (int a = 0; a < 2; ++a)
#pragma unroll
            for (int b = 0; b < 2; ++b)
#pragma unroll
                for (int m = 0; m < 4; ++m)
#pragma unroll
                    for (int n = 0; n < 2; ++n) acc[a][b][m][n] = (f32x4){0.f, 0.f, 0.f, 0.f};
        cur = nxt; cA = nA; cB = nB; ++ui;
    }
    PG8_WAIT_V(0);
    if (wr == 0) PG8_BAR;
    PG8_BAR;
    if constexpr (Epi::AFTER_DRAIN) { E.fused(acc, cur, wr, wc, fr, fq, lds, wid, lane); S.done(cur); }
    PG8_STAMP();
    if (STAMP && wid == 0) { stamps[lane] = lane < nts ? (((unsigned long long)(unsigned)ts_hi << 32) | (unsigned)ts_lo) : 0ull;
        if (lane == 62) stamps[62] = rt_entry; if (lane == 63) stamps[63] = (unsigned long long)wall_clock64(); }
#undef PG8_STAMP
#undef PG8_SA
#undef PG8_SB
#undef PG8_STAGE
#undef PG8_LDA
#undef PG8_LDB
#undef PG8_MMA
#undef PG8_WAIT_V
#undef PG8_WAIT_L
#undef PG8_BAR
#undef PG8_SCHED
}
}

#define XB_TMO      128
#define XB_XCNT(j)  (256  + 64 * (j))
#define XB_XSUB(j)  (1280 + 64 * (j))
#define XB_XGEN(j)  (2304 + 64 * (j))
#define XB_TOP      3328
#define XB_TOPGEN   3392
#define XCD_BAR_WORDS 3456
#define XB_SPIN_CAP (1u << 18)
#define LAS __attribute__((address_space(3)))

__device__ __forceinline__ unsigned xb_ld(unsigned* p)              { return __hip_atomic_load(p, __ATOMIC_RELAXED, __HIP_MEMORY_SCOPE_AGENT); }
__device__ __forceinline__ unsigned xb_add(unsigned* p, unsigned v) { return __hip_atomic_fetch_add(p, v, __ATOMIC_RELAXED, __HIP_MEMORY_SCOPE_AGENT); }
__device__ __forceinline__ unsigned xb_xcc_id() { return (unsigned)__builtin_amdgcn_s_getreg((3 << 11) | 20) & 0xFu; }
#define XB_SPIN(cond, bar) do { unsigned _sp = 0; while (cond) { __builtin_amdgcn_s_sleep(1); \
    if ((++_sp & 255u) == 0u) { if (xb_ld(&(bar)[XB_TMO])) break; if (_sp > XB_SPIN_CAP) { atomicAdd(&(bar)[XB_TMO], 1u); break; } } } } while (0)

struct XcdBarrier {
    unsigned* bar; unsigned x;
    volatile LAS unsigned* st;
};

__device__ __forceinline__ XcdBarrier xcd_barrier_post(unsigned* bar, volatile LAS unsigned* st) {
    XcdBarrier b; b.bar = bar; b.x = xb_xcc_id(); b.st = st;
    if (threadIdx.x == 0) (void)xb_add(&bar[XB_XCNT(b.x)], 1u);
    return b;
}
__device__ __forceinline__ void xcd_barrier_complete(unsigned* bar, unsigned x, unsigned& nloc, unsigned& nx) {
    const unsigned G = gridDim.x * gridDim.y * gridDim.z;
    unsigned sum, cnt, mine, sp = 0u;
    for (;;) {
        sum = 0u; cnt = 0u; mine = 0u;
#pragma unroll
        for (unsigned j = 0; j < 16; ++j) { const unsigned c = xb_ld(&bar[XB_XCNT(j)]); sum += c; cnt += (c > 0u) ? 1u : 0u; mine = (j == x) ? c : mine; }
        if (sum == G) break;
        __builtin_amdgcn_s_sleep(1);
        if ((++sp & 255u) == 0u) { if (xb_ld(&bar[XB_TMO])) break; if (sp > XB_SPIN_CAP) { atomicAdd(&bar[XB_TMO], 1u); break; } }
    }
    nloc = mine > 0u ? mine : 1u; nx = cnt > 0u ? cnt : 1u;
}

__device__ __forceinline__ void xcd_barrier(const XcdBarrier& b) {
    asm volatile("s_waitcnt vmcnt(0)" ::: "memory");
    __syncthreads();
    if (threadIdx.x == 0) {
        unsigned* bar = b.bar;
        __builtin_amdgcn_s_waitcnt(0);
        unsigned nloc = b.st[0], nx = b.st[1];
        if (nloc == 0u) { xcd_barrier_complete(bar, b.x, nloc, nx); b.st[0] = nloc; b.st[1] = nx; }
        const unsigned old = xb_add(&bar[XB_XSUB(b.x)], 1u);
        const unsigned gen = old / nloc;
        if (old + 1u == (gen + 1u) * nloc) {
            __builtin_amdgcn_fence(__ATOMIC_RELEASE, "agent");
            asm volatile("s_waitcnt vmcnt(0)" ::: "memory");
            const unsigned og = xb_add(&bar[XB_TOP], 1u);
            const unsigned tg = og / nx;
            if (og + 1u == (tg + 1u) * nx) xb_add(&bar[XB_TOPGEN], 1u);
            else XB_SPIN(xb_ld(&bar[XB_TOPGEN]) == tg, bar);
            __builtin_amdgcn_fence(__ATOMIC_ACQUIRE, "agent");
            xb_add(&bar[XB_XGEN(b.x)], 1u);
            asm volatile("s_waitcnt vmcnt(0)" ::: "memory");
        } else {
            XB_SPIN(xb_ld(&bar[XB_XGEN(b.x)]) == gen, bar);
            __builtin_amdgcn_fence(__ATOMIC_ACQUIRE, "agent");
            asm volatile("s_waitcnt vmcnt(0)" ::: "memory");
        }
    }
    __syncthreads();
}

namespace hk {
typedef unsigned short bf16_t;
typedef short bf16x8 __attribute__((ext_vector_type(8)));
typedef short bf16x4 __attribute__((ext_vector_type(4)));
typedef float f32x4 __attribute__((ext_vector_type(4)));
typedef float f32x16 __attribute__((ext_vector_type(16)));
typedef unsigned u32x4 __attribute__((ext_vector_type(4)));
typedef unsigned u32x2 __attribute__((ext_vector_type(2)));
#define HK_LAS __attribute__((address_space(3)))
#define HK_DI __device__ __forceinline__

constexpr int NTOK = 16384, DM = 4096, SEQ = 4096, NBATCH = 4;
constexpr int NP = 15104;
constexpr int QA_OFF = 0, CKV_OFF = 2048, QI_OFF = 2560, QB_OFF = 4608, KB_OFF = 6656, VB_OFF = 8704, Z_OFF = 10752, KI_OFF = 14848, WI_OFF = 14912;
constexpr int DRNN = 5120, NP2 = 10240;
constexpr int NTHREADS = 512;
constexpr int LDS_BYTES = 160 * 1024;
constexpr int LDS_MISC = 159 * 1024;
constexpr int BT_PITCH = 132;
constexpr float ATTN_SCALE = 0.08838834764831845f;
constexpr float EPS = 1e-6f;

constexpr size_t WS_CTL = 0;
constexpr size_t WS_BT = 256 * 1024;
constexpr size_t WS_LC = 288 * 1024;
constexpr size_t WS_KMEAN = 320 * 1024;
constexpr size_t WS_CARRY = 1024 * 1024;
constexpr size_t WS_RWIN_T = 8ull * 1024 * 1024;
constexpr size_t WS_RWOUT_T = WS_RWIN_T + 10240ull * 4096 * 2;
constexpr size_t WS_WG_T = WS_RWOUT_T + 4096ull * 5120 * 2;
constexpr size_t WS_L0 = WS_WG_T + 16ull * 768 * 384 * 2;
constexpr size_t WS_WIN_T = WS_L0;
constexpr size_t WS_WOUT_T = WS_WIN_T + 15104ull * 4096 * 2;
constexpr size_t WS_WUK = WS_WOUT_T + 4096ull * 4096 * 2;
constexpr size_t WS_WUVT = WS_WUK + 16ull * 512 * 256 * 2;
constexpr size_t WS_H = WS_WUVT + 16ull * 256 * 512 * 2;
constexpr size_t WS_PROJ = WS_H + 16384ull * 4096 * 2;
constexpr size_t WS_IDX = WS_PROJ + 16384ull * NP * 2;
constexpr size_t WS_CKVN = WS_IDX + 16384ull * 256 * 2;
constexpr size_t WS_KIN = WS_CKVN + 16384ull * 512 * 2;
constexpr size_t WS_WI = WS_KIN + 16384ull * 64 * 2;
constexpr size_t WS_VT = WS_WI + 16384ull * 32 * 4;
constexpr size_t WS_END0 = WS_VT + 4ull * 16 * 128 * 4096 * 2;
constexpr size_t WS_H1 = WS_L0;
constexpr size_t WS_XRZ = WS_H1 + 16384ull * 4096 * 2;
constexpr size_t WS_XC = WS_XRZ + 16384ull * NP2 * 2;
constexpr size_t WS_BB = WS_XC + 16384ull * DRNN * 2 + 4096;
constexpr size_t WS_CARRY2 = WS_BB + 16384ull * DRNN * 2;
constexpr size_t WS_END1 = WS_CARRY2 + 2ull * 4 * 64 * 5120 * 4;
constexpr size_t WS_NEED = WS_END0 > WS_END1 ? WS_END0 : WS_END1;

HK_DI float bf2f(unsigned short b) { return __uint_as_float(((unsigned)b) << 16); }
HK_DI float bflo(unsigned u) { return __uint_as_float(u << 16); }
HK_DI float bfhi(unsigned u) { return __uint_as_float(u & 0xffff0000u); }
typedef __bf16 hk_bf2 __attribute__((ext_vector_type(2)));
typedef float hk_f2 __attribute__((ext_vector_type(2)));
HK_DI unsigned pk2(float lo, float hi) { const hk_f2 v = {lo, hi}; const hk_bf2 r = __builtin_convertvector(v, hk_bf2); return __builtin_bit_cast(unsigned, r); }
HK_DI unsigned short f2bf(float f) { return (unsigned short)(pk2(f, 0.f) & 0xffffu); }
HK_DI float silu_f(float v) { return v * __builtin_amdgcn_rcpf(1.0f + __expf(-v)); }
HK_DI float sigmoid_f(float v) { return __builtin_amdgcn_rcpf(1.0f + __expf(-v)); }
HK_DI float wave_sum(float v) {
#pragma unroll
    for (int o = 32; o >= 1; o >>= 1) v += __shfl_xor(v, o);
    return v;
}
HK_DI float rows_max(float x) {
    auto r = __builtin_amdgcn_permlane16_swap(__float_as_uint(x), __float_as_uint(x), false, false); x = fmaxf(__uint_as_float(r[0]), __uint_as_float(r[1]));
    r = __builtin_amdgcn_permlane32_swap(__float_as_uint(x), __float_as_uint(x), false, false); return fmaxf(__uint_as_float(r[0]), __uint_as_float(r[1]));
}
HK_DI float rows_sum(float x) {
    auto r = __builtin_amdgcn_permlane16_swap(__float_as_uint(x), __float_as_uint(x), false, false); x = __uint_as_float(r[0]) + __uint_as_float(r[1]);
    r = __builtin_amdgcn_permlane32_swap(__float_as_uint(x), __float_as_uint(x), false, false); return __uint_as_float(r[0]) + __uint_as_float(r[1]);
}
HK_DI int t5_bucket(int d) {
    if (d < 16) return d;
    int b = 16;
    b += d >= 19; b += d >= 21; b += d >= 24; b += d >= 27; b += d >= 31; b += d >= 35; b += d >= 40; b += d >= 46;
    b += d >= 52; b += d >= 59; b += d >= 67; b += d >= 77; b += d >= 87; b += d >= 99; b += d >= 113;
    return b;
}

struct Args { const float* in[20]; float* out; unsigned char* ws; int ph_lo, ph_hi, li, pad; };

struct EpiBf16Silu {
    static constexpr bool PERM = true, AFTER_DRAIN = false;
    bf16_t* O; int ldc; int silu_lo, silu_hi; int pn0;
    __device__ __forceinline__ void operator()(const pg8::f32x4 (&acc)[2][2][4][2], const pg8::Unit& u, int wr, int wc, int fr, int fq) const {
        const int pn = u.pn + pn0;
        const int row0 = u.pm * 256 + wr * 64 + fr; const int col0 = pn * 256 + wc * 32 + 8 * fq;
        const bool act = (pn >= silu_lo) && (pn < silu_hi);
#pragma unroll
        for (int ai = 0; ai < 2; ++ai)
#pragma unroll
            for (int m = 0; m < 4; ++m) { bf16_t* rowp = O + (size_t)(row0 + ai * 128 + m * 16) * ldc + col0;
#pragma unroll
                for (int bj = 0; bj < 2; ++bj) { pg8::f32x4 v0 = acc[ai][bj][m][0], v1 = acc[ai][bj][m][1];
                    if (act) {
#pragma unroll
                        for (int j = 0; j < 4; ++j) { v0[j] = silu_f(v0[j]); v1[j] = silu_f(v1[j]); } }
                    u32x4 w; w.x = pk2(v0[0], v0[1]); w.y = pk2(v0[2], v0[3]); w.z = pk2(v1[0], v1[1]); w.w = pk2(v1[2], v1[3]);
                    *(u32x4*)(rowp + bj * 128) = w; } }
    }
};
struct EpiResidStats {
    static constexpr bool PERM = true, AFTER_DRAIN = false;
    bf16_t* O; int ldc; const float* R; int ldr; float* ST;
    __device__ __forceinline__ void operator()(const pg8::f32x4 (&acc)[2][2][4][2], const pg8::Unit& u, int wr, int wc, int fr, int fq) const {
        const int row0 = u.pm * 256 + wr * 64 + fr; const int col0 = u.pn * 256 + wc * 32 + 8 * fq;
#pragma unroll
        for (int ai = 0; ai < 2; ++ai)
#pragma unroll
            for (int m = 0; m < 4; ++m) { const int row = row0 + ai * 128 + m * 16; bf16_t* rowp = O + (size_t)row * ldc + col0; float ss = 0.f;
#pragma unroll
                for (int bj = 0; bj < 2; ++bj) { pg8::f32x4 v0 = acc[ai][bj][m][0], v1 = acc[ai][bj][m][1];
                    const float4* rp = (const float4*)(R + (size_t)row * ldr + col0 + bj * 128); const float4 r0 = rp[0], r1 = rp[1];
                    v0[0] += r0.x; v0[1] += r0.y; v0[2] += r0.z; v0[3] += r0.w; v1[0] += r1.x; v1[1] += r1.y; v1[2] += r1.z; v1[3] += r1.w;
                    ss += (v0[0] * v0[0] + v0[1] * v0[1]) + (v0[2] * v0[2] + v0[3] * v0[3]) + (v1[0] * v1[0] + v1[1] * v1[1]) + (v1[2] * v1[2] + v1[3] * v1[3]);
                    u32x4 w; w.x = pk2(v0[0], v0[1]); w.y = pk2(v0[2], v0[3]); w.z = pk2(v1[0], v1[1]); w.w = pk2(v1[2], v1[3]);
                    *(u32x4*)(rowp + bj * 128) = w; }
                ss = rows_sum(ss);
                if (fq == 0) ST[(size_t)row * 64 + 4 * u.pn + wc] = ss; }
    }
};
struct EpiBf16SiluRow {
    static constexpr bool PERM = true, AFTER_DRAIN = false;
    bf16_t* O; int ldc; int silu_lo, silu_hi; const HK_LAS float* rs;
    __device__ __forceinline__ void operator()(const pg8::f32x4 (&acc)[2][2][4][2], const pg8::Unit& u, int wr, int wc, int fr, int fq) const {
        const int rl0 = wr * 64 + fr; const int col0 = u.pn * 256 + wc * 32 + 8 * fq;
        const bool act = (u.pn >= silu_lo) && (u.pn < silu_hi);
#pragma unroll
        for (int ai = 0; ai < 2; ++ai)
#pragma unroll
            for (int m = 0; m < 4; ++m) { const int rl = rl0 + ai * 128 + m * 16; const float sc = rs[rl]; bf16_t* rowp = O + (size_t)(u.pm * 256 + rl) * ldc + col0;
#pragma unroll
                for (int bj = 0; bj < 2; ++bj) { pg8::f32x4 v0 = acc[ai][bj][m][0] * sc, v1 = acc[ai][bj][m][1] * sc;
                    if (act) {
#pragma unroll
                        for (int j = 0; j < 4; ++j) { v0[j] = silu_f(v0[j]); v1[j] = silu_f(v1[j]); } }
                    u32x4 w; w.x = pk2(v0[0], v0[1]); w.y = pk2(v0[2], v0[3]); w.z = pk2(v1[0], v1[1]); w.w = pk2(v1[2], v1[3]);
                    *(u32x4*)(rowp + bj * 128) = w; } }
    }
};
HK_DI pg8::Gemm mk_gemm(const bf16_t* A, const bf16_t* Bt, int M, int N, int K) { pg8::Gemm g; g.A = A; g.Bt = Bt; g.M = M; g.N = N; g.K = K; g.lda = K; g.ldb = K; g.za = 0; g.zb = 0; g.nz = 1; return g; }
HK_DI pg8::Gemm mk_gemm_b(const bf16_t* A, const bf16_t* Bt, int M, int N, int K, int lda, int ldb, size_t za, size_t zb, int nz) { pg8::Gemm g; g.A = A; g.Bt = Bt; g.M = M; g.N = N; g.K = K; g.lda = lda; g.ldb = ldb; g.za = za; g.zb = zb; g.nz = nz; return g; }
struct EpiQlatP {
    static constexpr bool PERM = true, AFTER_DRAIN = false;
    bf16_t* Q;
    __device__ __forceinline__ void operator()(const pg8::f32x4 (&acc)[2][2][4][2], const pg8::Unit& u, int wr, int wc, int fr, int fq) const {
        const int row0 = u.pm * 256 + wr * 64 + fr; const int col0 = u.pz * 512 + u.pn * 256 + wc * 32 + 8 * fq;
#pragma unroll
        for (int ai = 0; ai < 2; ++ai)
#pragma unroll
            for (int m = 0; m < 4; ++m) { bf16_t* rowp = Q + (size_t)(row0 + ai * 128 + m * 16) * 8192 + col0;
#pragma unroll
                for (int bj = 0; bj < 2; ++bj) { const pg8::f32x4 v0 = acc[ai][bj][m][0], v1 = acc[ai][bj][m][1];
                    u32x4 w; w.x = pk2(v0[0], v0[1]); w.y = pk2(v0[2], v0[3]); w.z = pk2(v1[0], v1[1]); w.w = pk2(v1[2], v1[3]);
                    *(u32x4*)(rowp + bj * 128) = w; } }
    }
};
struct EpiOaP {
    static constexpr bool PERM = true, AFTER_DRAIN = false;
    bf16_t* Y; const bf16_t* PROJ;
    __device__ __forceinline__ void operator()(const pg8::f32x4 (&acc)[2][2][4][2], const pg8::Unit& u, int wr, int wc, int fr, int fq) const {
        const int row0 = u.pm * 256 + wr * 64 + fr; const int col0 = u.pz * 128 + wc * 32 + 8 * fq;
#pragma unroll
        for (int ai = 0; ai < 2; ++ai)
#pragma unroll
            for (int m = 0; m < 4; ++m) { const size_t row = (size_t)(row0 + ai * 128 + m * 16);
                const u32x4 g = *(const u32x4*)(PROJ + row * NP + Z_OFF + col0);
                const pg8::f32x4 v0 = acc[ai][0][m][0], v1 = acc[ai][0][m][1];
                u32x4 w; w.x = pk2(v0[0] * bflo(g.x), v0[1] * bfhi(g.x)); w.y = pk2(v0[2] * bflo(g.y), v0[3] * bfhi(g.y));
                w.z = pk2(v1[0] * bflo(g.z), v1[1] * bfhi(g.z)); w.w = pk2(v1[2] * bflo(g.w), v1[3] * bfhi(g.w));
                *(u32x4*)(Y + row * DM + col0) = w; }
    }
};
struct EpiGateP {
    static constexpr bool PERM = false, AFTER_DRAIN = false;
    bf16_t* LA; bf16_t* BB; const bf16_t* XC; const float* ba; const float* bx; const float* LC;
    __device__ __forceinline__ void operator()(const pg8::f32x4 (&acc)[2][2][4][2], const pg8::Unit& u, int wr, int wc, int fr, int fq) const {
        const int row0 = u.pm * 256 + wr * 64 + fr;
#pragma unroll
        for (int bj = 0; bj < 2; ++bj) {
            const int G = 8 * u.pn + 4 * bj + wc;
            if (G < 20) {
                const int c = 320 * u.pz + 16 * G + 4 * fq;
                const float4 va = *(const float4*)(ba + c), vx = *(const float4*)(bx + c), vl = *(const float4*)(LC + c);
                const float bav[4] = {va.x, va.y, va.z, va.w}, bxv[4] = {vx.x, vx.y, vx.z, vx.w}, lcv[4] = {vl.x, vl.y, vl.z, vl.w};
#pragma unroll
                for (int ai = 0; ai < 2; ++ai)
#pragma unroll
                    for (int m = 0; m < 4; ++m) { const size_t row = (size_t)(row0 + ai * 128 + m * 16);
                        const u32x2 xw = *(const u32x2*)(XC + row * DRNN + c);
                        const float xc[4] = {bflo(xw.x), bfhi(xw.x), bflo(xw.y), bfhi(xw.y)};
                        float la[4], bt[4];
#pragma unroll
                        for (int j = 0; j < 4; ++j) { const float r = sigmoid_f(acc[ai][bj][m][0][j] + bav[j]), ig = sigmoid_f(acc[ai][bj][m][1][j] + bxv[j]);
                            la[j] = r * lcv[j]; const float av = __expf(la[j]); const float m2 = fmaxf(1.0f - av * av, 0.f); bt[j] = __builtin_amdgcn_sqrtf(m2) * ig * xc[j]; }
                        u32x2 o1; o1.x = pk2(la[0], la[1]); o1.y = pk2(la[2], la[3]); *(u32x2*)(LA + row * NP2 + c) = o1;
                        u32x2 o2; o2.x = pk2(bt[0], bt[1]); o2.y = pk2(bt[2], bt[3]); *(u32x2*)(BB + row * DRNN + c) = o2; }
            }
        }
    }
};


template <class ColMap>
HK_DI void transpose_convert(HK_LAS unsigned char* lds, const float* __restrict__ src, int ldsrc, int K, int n_tiles, ColMap cmap, bf16_t* __restrict__ dst, int vblk, int nblk, const float* __restrict__ kscale = nullptr) {
    constexpr int U = 4;
    HK_LAS float* sm = (HK_LAS float*)lds;
    const int tid = threadIdx.x;
    const int ktiles = K / 128, total = n_tiles * ktiles;
    for (int it0 = vblk; it0 < total; it0 += U * nblk) {
        int c0[U], k0[U], nt[U]; float4 va[U], vb[U];
#pragma unroll
        for (int u = 0; u < U; ++u) { const int it = it0 + u * nblk; const int kt = it / n_tiles; nt[u] = it - kt * n_tiles; k0[u] = kt * 128; c0[u] = (it < total) ? cmap(nt[u]) : -2;
            if (c0[u] >= 0) { const int kr = tid >> 2, q = tid & 3; const float4* p = (const float4*)(src + (size_t)(k0[u] + kr) * ldsrc + c0[u] + 8 * q); va[u] = p[0]; vb[u] = p[1]; } }
#pragma unroll
        for (int u = 0; u < U; ++u) if (c0[u] >= 0) { const int kr = tid >> 2, q = tid & 3; HK_LAS float* d = sm + u * (32 * 130) + (8 * q) * 130 + kr;
            const float sc = kscale ? kscale[k0[u] + kr] : 1.0f;
            d[0] = va[u].x * sc; d[130] = va[u].y * sc; d[260] = va[u].z * sc; d[390] = va[u].w * sc; d[520] = vb[u].x * sc; d[650] = vb[u].y * sc; d[780] = vb[u].z * sc; d[910] = vb[u].w * sc; }
        __syncthreads();
#pragma unroll
        for (int u = 0; u < U; ++u) if (c0[u] >= -1) {
            const int kp = tid & 63, w = tid >> 6;
#pragma unroll
            for (int i = 0; i < 4; ++i) {
                const int n = w + 8 * i;
                unsigned o = 0u;
                if (c0[u] >= 0) { const float lo = sm[u * (32 * 130) + n * 130 + 2 * kp], hi = sm[u * (32 * 130) + n * 130 + 2 * kp + 1]; o = pk2(lo, hi); }
                *(unsigned*)(dst + (size_t)(nt[u] * 32 + n) * K + k0[u] + 2 * kp) = o;
            }
        }
        __syncthreads();
    }
}

HK_DI void rmsnorm_rows_bf16(const float* __restrict__ x, const float* __restrict__ g, bf16_t* __restrict__ y, int nrows, int gwave, int nwaves, int lane) {
    for (int row = gwave; row < nrows; row += nwaves) {
        const float4* xr = (const float4*)(x + (size_t)row * DM);
        float4 v[16]; float ss = 0.f;
#pragma unroll
        for (int i = 0; i < 16; ++i) { v[i] = xr[lane + 64 * i]; ss += v[i].x * v[i].x + v[i].y * v[i].y + v[i].z * v[i].z + v[i].w * v[i].w; }
        ss = wave_sum(ss);
        const float inv = rsqrtf(ss * (1.0f / DM) + EPS);
#pragma unroll
        for (int i = 0; i < 16; ++i) { const float4 gg = ((const float4*)g)[lane + 64 * i];
            u32x2 o; o.x = pk2(v[i].x * inv * gg.x, v[i].y * inv * gg.y); o.y = pk2(v[i].z * inv * gg.z, v[i].w * inv * gg.w);
            *(u32x2*)(y + (size_t)row * DM + 4 * (lane + 64 * i)) = o; }
    }
}

HK_DI void rmsnorm_res_rows(const float* __restrict__ x, const bf16_t* __restrict__ r, const float* __restrict__ g, float* __restrict__ out1, bf16_t* __restrict__ y, int nrows, int gwave, int nwaves, int lane) {
    for (int row = gwave; row < nrows; row += nwaves) {
        const float4* xr = (const float4*)(x + (size_t)row * DM); const u32x2* rr = (const u32x2*)(r + (size_t)row * DM);
        float4 v[16]; float ss = 0.f;
#pragma unroll
        for (int i = 0; i < 16; ++i) { v[i] = xr[lane + 64 * i]; const u32x2 w = rr[lane + 64 * i];
            v[i].x += bflo(w.x); v[i].y += bfhi(w.x); v[i].z += bflo(w.y); v[i].w += bfhi(w.y);
            ss += v[i].x * v[i].x + v[i].y * v[i].y + v[i].z * v[i].z + v[i].w * v[i].w; }
        ss = wave_sum(ss);
        const float inv = rsqrtf(ss * (1.0f / DM) + EPS);
#pragma unroll
        for (int i = 0; i < 16; ++i) { const float4 gg = ((const float4*)g)[lane + 64 * i];
            { u32x2 xw; xw.x = pk2(v[i].x, v[i].y); xw.y = pk2(v[i].z, v[i].w);
              ((u32x2*)(out1 + (size_t)row * DM + DM / 2))[lane + 64 * i] = xw; }
            u32x2 o; o.x = pk2(v[i].x * inv * gg.x, v[i].y * inv * gg.y); o.y = pk2(v[i].z * inv * gg.z, v[i].w * inv * gg.w);
            *(u32x2*)(y + (size_t)row * DM + 4 * (lane + 64 * i)) = o; }
    }
}

struct WinMap { HK_DI int operator()(int nt) const { const int n = nt * 32; return n < 4608 ? n : (n < 14848 ? n + 96 : (n < 14944 ? n - 14848 + 4608 : -1)); } };
struct IdMap { HK_DI int operator()(int nt) const { return nt * 32; } };
struct PadMap128 { HK_DI int operator()(int nt) const { return nt < 4 ? nt * 32 : -1; } };

HK_DI void phase0_prologue(HK_LAS unsigned char* lds, const Args& a) {
    const int tid = threadIdx.x, lane = tid & 63, wave = tid >> 6, blk = blockIdx.x, nblk = gridDim.x;
    unsigned char* ws = a.ws;
    transpose_convert(lds, a.in[4], 14944, 4096, NP / 32, WinMap(), (bf16_t*)(ws + WS_WIN_T), blk, nblk);
    transpose_convert(lds, a.in[10], 4096, 4096, 4096 / 32, IdMap(), (bf16_t*)(ws + WS_WOUT_T), blk, nblk);
    transpose_convert(lds, a.in[11], 10240, 4096, 10240 / 32, IdMap(), (bf16_t*)(ws + WS_RWIN_T), blk, nblk, a.in[1] + DM);
    transpose_convert(lds, a.in[19], 4096, 5120, 4096 / 32, IdMap(), (bf16_t*)(ws + WS_RWOUT_T), blk, nblk);
    for (int h = 0; h < 16; ++h)
        transpose_convert(lds, a.in[7] + (size_t)h * 512 * 128, 128, 512, 256 / 32, PadMap128(), (bf16_t*)(ws + WS_WUVT) + (size_t)h * 256 * 512, blk, nblk);
    const size_t gtid = (size_t)blk * NTHREADS + tid, gstride = (size_t)nblk * NTHREADS;
    { const float4* s = (const float4*)a.in[6]; u32x2* d = (u32x2*)(ws + WS_WUK);
      for (size_t i = gtid; i < 16ull * 512 * 256 / 4; i += gstride) { const size_t rowi = i >> 6; const int k4 = (int)(i & 63);
          u32x2 o; o.x = 0u; o.y = 0u; if (k4 < 32) { const float4 v = s[rowi * 32 + k4]; o.x = pk2(v.x, v.y); o.y = pk2(v.z, v.w); } d[i] = o; } }
    { bf16_t* d = (bf16_t*)(ws + WS_WG_T); const float* wa = a.in[14]; const float* wx = a.in[16];
      for (size_t i = gtid; i < 16ull * 768 * 384; i += gstride) { const int k = (int)(i % 384); const size_t r = i / 384; const int jp = (int)(r % 768), z = (int)(r / 768);
          const int grp = jp >> 5, ii = jp & 31; const float* w = (ii < 16) ? wa : wx; const int col = 16 * grp + (ii & 15);
          d[i] = (grp < 20 && k < 320) ? f2bf(w[((size_t)z * 320 + k) * 320 + col]) : (bf16_t)0; } }
    { float* bt = (float*)(ws + WS_BT); const float* rb = a.in[3];
      for (size_t i = gtid; i < 32 * 129; i += gstride) { const int h = (int)(i / 129), d = (int)(i % 129); bt[h * BT_PITCH + d] = rb[t5_bucket(d) * 32 + h]; } }
    { float* lc = (float*)(ws + WS_LC); const float* lam = a.in[18];
      for (size_t i = gtid; i < DRNN; i += gstride) lc[i] = -8.0f * log1pf(expf(-lam[i])); }
    rmsnorm_rows_bf16(a.in[0], a.in[1], (bf16_t*)(ws + WS_H), NTOK, blk * 8 + wave, nblk * 8, lane);
}

HK_DI void phase2_post(HK_LAS unsigned char* lds, const Args& a) {
    const int tid = threadIdx.x, lane = tid & 63, wave = tid >> 6, blk = blockIdx.x, nblk = gridDim.x;
    unsigned char* ws = a.ws;
    const bf16_t* PROJ = (const bf16_t*)(ws + WS_PROJ);
    { bf16_t* CKVN = (bf16_t*)(ws + WS_CKVN); bf16_t* KIN = (bf16_t*)(ws + WS_KIN); float* WI = (float*)(ws + WS_WI);
      const float* kvg = a.in[5]; const float* kg = a.in[8]; const float* kb = a.in[9];
      for (int tok = blk * 8 + wave; tok < NTOK; tok += nblk * 8) {
          const bf16_t* pr = PROJ + (size_t)tok * NP;
          const u32x4 c = *(const u32x4*)(pr + CKV_OFF + 8 * lane);
          float v[8] = {bflo(c.x), bfhi(c.x), bflo(c.y), bfhi(c.y), bflo(c.z), bfhi(c.z), bflo(c.w), bfhi(c.w)};
          float ss = 0.f;
#pragma unroll
          for (int j = 0; j < 8; ++j) ss += v[j] * v[j];
          ss = wave_sum(ss);
          const float inv = rsqrtf(ss * (1.0f / 512.0f) + EPS);
          const float4 g0 = ((const float4*)kvg)[2 * lane], g1 = ((const float4*)kvg)[2 * lane + 1];
          u32x4 o; o.x = pk2(v[0] * inv * g0.x, v[1] * inv * g0.y); o.y = pk2(v[2] * inv * g0.z, v[3] * inv * g0.w);
          o.z = pk2(v[4] * inv * g1.x, v[5] * inv * g1.y); o.w = pk2(v[6] * inv * g1.z, v[7] * inv * g1.w);
          *(u32x4*)(CKVN + (size_t)tok * 512 + 8 * lane) = o;
          const float kv = bf2f(pr[KI_OFF + lane]);
          const float mu = wave_sum(kv) * (1.0f / 64.0f);
          const float dv = kv - mu;
          const float var = wave_sum(dv * dv) * (1.0f / 64.0f);
          KIN[(size_t)tok * 64 + lane] = f2bf(dv * rsqrtf(var + EPS) * kg[lane] + kb[lane]);
          if (lane < 32) WI[(size_t)tok * 32 + lane] = bf2f(pr[WI_OFF + lane]);
      } }
    { float* KM = (float*)(ws + WS_KMEAN); HK_LAS float* red = (HK_LAS float*)lds;
      const int cg = tid & 15, rg = tid >> 4;
      for (int it = blk; it < 1024; it += nblk) {
          const int h = it & 15, bk = it >> 4;
          const bf16_t* base = PROJ + (size_t)(bk * 256 + rg) * NP + KB_OFF + h * 128 + 8 * cg;
          float sacc[8] = {0.f, 0.f, 0.f, 0.f, 0.f, 0.f, 0.f, 0.f};
#pragma unroll
          for (int r = 0; r < 8; ++r) { const u32x4 w = *(const u32x4*)(base + (size_t)(32 * r) * NP);
              sacc[0] += bflo(w.x); sacc[1] += bfhi(w.x); sacc[2] += bflo(w.y); sacc[3] += bfhi(w.y); sacc[4] += bflo(w.z); sacc[5] += bfhi(w.z); sacc[6] += bflo(w.w); sacc[7] += bfhi(w.w); }
          __syncthreads();
          *(HK_LAS f32x4*)(red + rg * 128 + 8 * cg) = (f32x4){sacc[0], sacc[1], sacc[2], sacc[3]};
          *(HK_LAS f32x4*)(red + rg * 128 + 8 * cg + 4) = (f32x4){sacc[4], sacc[5], sacc[6], sacc[7]};
          __syncthreads();
          if (tid < 128) { float t = 0.f;
#pragma unroll
              for (int g2 = 0; g2 < 32; ++g2) t += red[g2 * 128 + tid];
              KM[(size_t)it * 128 + tid] = t * (1.0f / 256.0f); }
      }
      __syncthreads(); }
    { bf16_t* VT = (bf16_t*)(ws + WS_VT); HK_LAS bf16_t* sm = (HK_LAS bf16_t*)lds;
      for (int it = blk; it < 4 * 16 * 64; it += nblk) {
          const int tt = it & 63, bh = it >> 6, h = bh & 15, b = bh >> 4;
          __syncthreads();
#pragma unroll
          for (int i = 0; i < 2; ++i) { const int c = tid + 512 * i, r = c >> 4, dc = c & 15;
              const u32x4 w = *(const u32x4*)(PROJ + (size_t)(b * 4096 + tt * 64 + r) * NP + VB_OFF + h * 128 + 8 * dc);
              const int rp = (r & 32) | ((r & 12) << 1) | ((r & 16) >> 2) | (r & 3);
              HK_LAS bf16_t* p = sm + (8 * dc) * 72 + rp;
              p[0] = (bf16_t)(w.x & 0xffff); p[72] = (bf16_t)(w.x >> 16); p[144] = (bf16_t)(w.y & 0xffff); p[216] = (bf16_t)(w.y >> 16);
              p[288] = (bf16_t)(w.z & 0xffff); p[360] = (bf16_t)(w.z >> 16); p[432] = (bf16_t)(w.w & 0xffff); p[504] = (bf16_t)(w.w >> 16); }
          __syncthreads();
#pragma unroll
          for (int i = 0; i < 2; ++i) { const int c = tid + 512 * i, d = c >> 3, tc = c & 7;
              const u32x4 w = *(const HK_LAS u32x4*)(sm + d * 72 + 8 * tc);
              *(u32x4*)(VT + ((size_t)bh * 128 + d) * 4096 + tt * 64 + 8 * tc) = w; }
      }
      __syncthreads(); }
}

HK_DI unsigned f2ord(float x) { const unsigned u = __float_as_uint(x); return (u & 0x80000000u) ? ~u : (u | 0x80000000u); }

HK_DI void phase3_indexer(HK_LAS unsigned char* lds, const Args& a) {
    const int tid = threadIdx.x, lane = tid & 63, wave = __builtin_amdgcn_readfirstlane(tid >> 6);
    unsigned char* ws = a.ws;
    const bf16_t* PROJ = (const bf16_t*)(ws + WS_PROJ); const bf16_t* KIN = (const bf16_t*)(ws + WS_KIN); const float* WI = (const float*)(ws + WS_WI);
    bf16_t* IDX = (bf16_t*)(ws + WS_IDX);
    const int W = blockIdx.x * 8 + wave, NW = gridDim.x * 8;
    const int l31 = lane & 31, hf2 = lane >> 5;
    const unsigned rdb = (unsigned)(uintptr_t)lds + l31 * 128 + 16 * (hf2 ^ ((l31 >> 1) & 7));
    const int drow = tid >> 3, dpos = tid & 7;
    const int dsrc = drow * 64 + 8 * (dpos ^ ((drow >> 1) & 7));
    const int wave1024 = (wave & 7) * 1024;
    for (int q0 = W, qi = 0; q0 < NTOK; q0 += NW, ++qi) {
        int q = q0; int tmaxb;
        if (NW == 2048) { const int bb = qi >> 1; q = bb * 4096 + ((qi & 1) ? 4095 - W : W); tmaxb = (qi & 1) ? 4095 - 8 * (int)blockIdx.x : 8 * (int)blockIdx.x + 7; }
        else { const int qlast = q0 - wave + 7; tmaxb = ((q0 - wave) >> 12) == (qlast >> 12) ? (qlast & 4095) : 4095; }
        const int b = q >> 12, t = q & 4095;
        bf16_t* idx_out = IDX + (size_t)q * 256;
        if (tmaxb < 256) {
#pragma unroll
            for (int k = 0; k < 4; ++k) { const int s = lane + 64 * k; idx_out[s] = (bf16_t)(s <= t ? s : 0); }
            continue;
        }
        const bf16_t* qrow = PROJ + (size_t)q * NP + QI_OFF + l31 * 64 + 8 * hf2;
        bf16x8 A[4];
#pragma unroll
        for (int ks = 0; ks < 4; ++ks) A[ks] = *(const bf16x8*)(qrow + 16 * ks);
        float wv[16];
#pragma unroll
        for (int r = 0; r < 16; ++r) wv[r] = WI[(size_t)q * 32 + (r & 3) + 8 * (r >> 2) + 4 * hf2];
        const bf16_t* kb = KIN + (size_t)(b * 4096) * 64 + dsrc;
        const int ngb = (tmaxb >> 6) + 1;
        const int ng = ngb;
        unsigned key[64];
        asm volatile("s_waitcnt vmcnt(0)" ::: "memory");
        __syncthreads();
#define HK_IDX_ISSUE(j) __builtin_amdgcn_global_load_lds((const unsigned*)(kb + (size_t)(j) * 4096), (HK_LAS unsigned*)(lds + ((j) & 7) * 8192 + wave1024), 16, 0, 0)
#define HK_IDX_RELU(x) __int_as_float(max(__float_as_int(x), 0))
#define HK_IDX_TILE(j, hf, pout) do { f32x16 a0; \
            _Pragma("unroll") for (int r = 0; r < 16; ++r) a0[r] = 0.f; \
            _Pragma("unroll") for (int ks = 0; ks < 4; ++ks) a0 = __builtin_amdgcn_mfma_f32_32x32x16_bf16(A[ks], *(const HK_LAS bf16x8*)(uintptr_t)((rdb ^ (unsigned)(32 * ks)) + ((j) & 7) * 8192 + 4096 * (hf)), a0, 0, 0, 0); \
            float u0 = 0.f, u1 = 0.f; \
            _Pragma("unroll") for (int r = 0; r < 16; r += 2) { u0 += wv[r] * HK_IDX_RELU(a0[r]); u1 += wv[r + 1] * HK_IDX_RELU(a0[r + 1]); } \
            pout = u0 + u1; } while (0)
        HK_IDX_ISSUE(0); HK_IDX_ISSUE(1); HK_IDX_ISSUE(2); HK_IDX_ISSUE(3); HK_IDX_ISSUE(4);
        if (5 < ngb) HK_IDX_ISSUE(5);
        if (6 < ngb) HK_IDX_ISSUE(6);
#pragma unroll
        for (int j = 0; j < 64; ++j) {
            if (j < ngb) {
                const int rem = ngb - 1 - j;
                if (rem >= 6) asm volatile("s_waitcnt vmcnt(6)" ::: "memory"); else if (rem == 5) asm volatile("s_waitcnt vmcnt(5)" ::: "memory");
                else if (rem == 4) asm volatile("s_waitcnt vmcnt(4)" ::: "memory"); else if (rem == 3) asm volatile("s_waitcnt vmcnt(3)" ::: "memory");
                else if (rem == 2) asm volatile("s_waitcnt vmcnt(2)" ::: "memory"); else if (rem == 1) asm volatile("s_waitcnt vmcnt(1)" ::: "memory"); else asm volatile("s_waitcnt vmcnt(0)" ::: "memory");
                __builtin_amdgcn_s_barrier();
                asm volatile("" ::: "memory");
                if (j + 7 < ngb) HK_IDX_ISSUE(j + 7);
                float p0, p1;
                HK_IDX_TILE(j, 0, p0);
                HK_IDX_TILE(j, 1, p1);
                const auto sw_ = __builtin_amdgcn_permlane32_swap(__float_as_uint(p0), __float_as_uint(p1), false, false);
                const float v_ = __uint_as_float(sw_[0]) + __uint_as_float(sw_[1]);
                key[j] = (64 * j + lane <= t) ? f2ord(v_) : 0u;
            } else key[j] = 0u;
        }
#undef HK_IDX_ISSUE
#undef HK_IDX_RELU
#undef HK_IDX_TILE
        unsigned T = 0u;
        for (int bit = 31; bit >= 0; --bit) {
            const unsigned cand = T | (1u << bit);
            int cnt = 0;
            int ngx = ng; asm volatile("" : "+s"(ngx));
#pragma unroll
            for (int g8 = 0; g8 < 8; ++g8) if (8 * g8 < ngx) {
#pragma unroll
                for (int jj = 0; jj < 8; ++jj) cnt += __popcll(__ballot(key[8 * g8 + jj] >= cand)); }
            if (cnt >= 256) { T = cand; if (cnt == 256) break; }
        }
        int base = 0; int ng1 = ng, ng2 = ng; asm volatile("" : "+s"(ng1)); asm volatile("" : "+s"(ng2));
#pragma unroll
        for (int j = 0; j < 64; ++j) if ((j & ~7) < ng1) {
            const bool sel = key[j] > T; const unsigned long long m = __ballot(sel);
            const int pos = base + __builtin_amdgcn_mbcnt_hi((unsigned)(m >> 32), __builtin_amdgcn_mbcnt_lo((unsigned)m, 0u));
            if (sel && pos < 256) idx_out[pos] = (bf16_t)(64 * j + lane);
            base += __popcll(m);
        }
#pragma unroll
        for (int j = 0; j < 64; ++j) if ((j & ~7) < ng2) {
            const bool sel = key[j] == T; const unsigned long long m = __ballot(sel);
            const int pos = base + __builtin_amdgcn_mbcnt_hi((unsigned)(m >> 32), __builtin_amdgcn_mbcnt_lo((unsigned)m, 0u));
            if (sel && pos < 256) idx_out[pos] = (bf16_t)(64 * j + lane);
            base += __popcll(m);
        }
    }
}

template <int OFF>
HK_DI void tr4(u32x2 (&r)[4], unsigned a0, unsigned a1, unsigned a2, unsigned a3) {
    asm volatile("ds_read_b64_tr_b16 %0, %4 offset:%8\n\tds_read_b64_tr_b16 %1, %5 offset:%8\n\tds_read_b64_tr_b16 %2, %6 offset:%8\n\tds_read_b64_tr_b16 %3, %7 offset:%8\n\ts_waitcnt lgkmcnt(0)"
                 : "=&v"(r[0]), "=&v"(r[1]), "=&v"(r[2]), "=&v"(r[3]) : "v"(a0), "v"(a1), "v"(a2), "v"(a3), "n"(OFF) : "memory");
}
#define HK_TR4_ASM(OFFS) "ds_read_b64_tr_b16 %0, %4 offset:" OFFS "\n\tds_read_b64_tr_b16 %1, %5 offset:" OFFS "\n\tds_read_b64_tr_b16 %2, %6 offset:" OFFS "\n\tds_read_b64_tr_b16 %3, %7 offset:" OFFS
template <int OFF>
HK_DI void dsa_rd4(u32x2 (&r)[4], unsigned a0, unsigned a1, unsigned a2, unsigned a3) {
    asm volatile("ds_read_b64_tr_b16 %0, %4 offset:%8\n\tds_read_b64_tr_b16 %1, %5 offset:%8\n\tds_read_b64_tr_b16 %2, %6 offset:%8\n\tds_read_b64_tr_b16 %3, %7 offset:%8"
                 : "=&v"(r[0]), "=&v"(r[1]), "=&v"(r[2]), "=&v"(r[3]) : "v"(a0), "v"(a1), "v"(a2), "v"(a3), "n"(OFF) : "memory");
}
template <int N> HK_DI void dsa_wait4(u32x2 (&r)[4]) { asm volatile("s_waitcnt lgkmcnt(%4)" : "+v"(r[0]), "+v"(r[1]), "+v"(r[2]), "+v"(r[3]) : "n"(N) : "memory"); }
template <int OFF>
HK_DI void dsa_pv16(f32x4 (&O)[16], unsigned a0in, const bf16x4 Pf) {
    u32x2 ra[4], rb[4];
    unsigned a0 = a0in; asm volatile("" : "+v"(a0));
    const unsigned a1 = a0 ^ 32u, a2 = a0 ^ 64u, a3 = a0 ^ 96u, a4 = a0 ^ 128u, a5 = a0 ^ 160u, a6 = a0 ^ 192u, a7 = a0 ^ 224u;
    dsa_rd4<OFF>(ra, a0, a1, a2, a3);
    dsa_rd4<OFF>(rb, a4, a5, a6, a7);
    dsa_wait4<4>(ra);
#pragma unroll
    for (int i = 0; i < 4; ++i) O[i] = __builtin_amdgcn_mfma_f32_16x16x16bf16_1k(__builtin_bit_cast(bf16x4, ra[i]), Pf, O[i], 0, 0, 0);
    __builtin_amdgcn_sched_barrier(0);
    dsa_rd4<OFF + 256>(ra, a0, a1, a2, a3);
    dsa_wait4<4>(rb);
#pragma unroll
    for (int i = 0; i < 4; ++i) O[4 + i] = __builtin_amdgcn_mfma_f32_16x16x16bf16_1k(__builtin_bit_cast(bf16x4, rb[i]), Pf, O[4 + i], 0, 0, 0);
    __builtin_amdgcn_sched_barrier(0);
    dsa_rd4<OFF + 256>(rb, a4, a5, a6, a7);
    dsa_wait4<4>(ra);
#pragma unroll
    for (int i = 0; i < 4; ++i) O[8 + i] = __builtin_amdgcn_mfma_f32_16x16x16bf16_1k(__builtin_bit_cast(bf16x4, ra[i]), Pf, O[8 + i], 0, 0, 0);
    dsa_wait4<0>(rb);
#pragma unroll
    for (int i = 0; i < 4; ++i) O[12 + i] = __builtin_amdgcn_mfma_f32_16x16x16bf16_1k(__builtin_bit_cast(bf16x4, rb[i]), Pf, O[12 + i], 0, 0, 0);
}
struct DsaSt { f32x4 O[16]; bf16x8 Bq[8]; float mrun, lsum; unsigned ad0, rbase; int t, nsel, fr, fq, lane; unsigned seq; volatile HK_LAS unsigned* flag_me; volatile HK_LAS unsigned* flag_pa; };
template <int BI>
HK_DI void dsa4_chunk(HK_LAS unsigned char* buf, HK_LAS unsigned char* xs_me, const HK_LAS unsigned char* xs_pa, const HK_LAS bf16_t* widx, const HK_LAS float* btl, DsaSt& st, const int kt, const float c2) {
    const u32x2 iw = *(const HK_LAS u32x2*)(widx + 16 * kt + 4 * st.fq);
    const int s4[4] = {(int)(iw.x & 0xffff), (int)(iw.x >> 16), (int)(iw.y & 0xffff), (int)(iw.y >> 16)};
    float bias4[4];
#pragma unroll
    for (int j = 0; j < 4; ++j) { int d = st.t - s4[j]; d = d < 0 ? 0 : (d > 128 ? 128 : d); bias4[j] = btl[st.fr * 129 + d]; }
    f32x4 acc = (f32x4){0.f, 0.f, 0.f, 0.f};
#pragma unroll
    for (int k4 = 0; k4 < 2; ++k4) {
        bf16x8 Af[4];
#pragma unroll
        for (int k3 = 0; k3 < 4; ++k3) Af[k3] = *(const HK_LAS bf16x8*)(uintptr_t)((st.rbase ^ (unsigned)(64 * k3)) + 8192 * BI + 256 * k4);
#pragma unroll
        for (int k3 = 0; k3 < 4; ++k3) acc = __builtin_amdgcn_mfma_f32_16x16x32_bf16(Af[k3], st.Bq[4 * k4 + k3], acc, 0, 0, 0);
    }
    *(HK_LAS f32x4*)(xs_me + 1024 * BI + 16 * st.lane) = acc;
    asm volatile("s_waitcnt lgkmcnt(0)" ::: "memory");
    *st.flag_me = st.seq;
    {
        unsigned spins = 0u;
        while ((unsigned)__builtin_amdgcn_readfirstlane(*st.flag_pa) < st.seq) { __builtin_amdgcn_s_sleep(1); if (++spins > (1u << 22)) break; }
    }
    asm volatile("" ::: "memory");
    acc += *(const HK_LAS f32x4*)(xs_pa + 1024 * BI + 16 * st.lane);
    st.seq += 1u;
    float v[4]; float tmax = -INFINITY;
#pragma unroll
    for (int j = 0; j < 4; ++j) { const int k = 16 * kt + 4 * st.fq + j;
        v[j] = (k < st.nsel) ? acc[j] * c2 + bias4[j] : -INFINITY; tmax = fmaxf(tmax, v[j]); }
    tmax = rows_max(tmax);
    const float mnew = fmaxf(st.mrun, tmax);
    const float msafe = (mnew == -INFINITY) ? 0.f : mnew;
    if (__ballot(mnew != st.mrun) != 0ull) {
        const float alpha = __builtin_amdgcn_exp2f(st.mrun - msafe);
        st.lsum *= alpha;
#pragma unroll
        for (int i = 0; i < 16; ++i) st.O[i] *= alpha;
    }
    st.mrun = mnew;
    float p[4];
#pragma unroll
    for (int j = 0; j < 4; ++j) { p[j] = __builtin_amdgcn_exp2f(v[j] - msafe); st.lsum += p[j]; }
    u32x2 pw; pw.x = pk2(p[0], p[1]); pw.y = pk2(p[2], p[3]);
    const bf16x4 Pf = __builtin_bit_cast(bf16x4, pw);
    dsa_pv16<8192 * BI>(st.O, st.ad0, Pf);
}
HK_DI void phase4_dsa(HK_LAS unsigned char* lds, const Args& a) {
    const int tid = threadIdx.x, lane = tid & 63, wave = __builtin_amdgcn_readfirstlane(tid >> 6), fr = lane & 15, fq = lane >> 4;
    const int pair = wave >> 1, hf = wave & 1;
    unsigned char* ws = a.ws;
    const bf16_t* CKVN = (const bf16_t*)(ws + WS_CKVN); const bf16_t* IDX = (const bf16_t*)(ws + WS_IDX); const float* BT = (const float*)(ws + WS_BT);
    bf16_t* QL = (bf16_t*)a.out;
    HK_LAS unsigned char* buf = lds + (wave & 7) * 16384;
    HK_LAS bf16_t* widx = (HK_LAS bf16_t*)(lds + 131072 + (wave & 7) * 512);
    HK_LAS unsigned char* xs_me = lds + 131072 + 4096 + (wave & 7) * 2048;
    const HK_LAS unsigned char* xs_pa = lds + 131072 + 4096 + ((wave ^ 1) & 7) * 2048;
    HK_LAS float* btl = (HK_LAS float*)(lds + 131072 + 4096 + 16384);
    for (int i = tid; i < 16 * 129; i += NTHREADS) btl[i] = BT[(i / 129) * BT_PITCH + (i % 129)] * 1.4426950408889634f;
    DsaSt st; st.fr = fr; st.fq = fq; st.lane = lane; st.seq = 1u;
    st.flag_me = (volatile HK_LAS unsigned*)(lds + 131072 + 4096 + 16384 + 8448 + (wave & 7) * 64);
    st.flag_pa = (volatile HK_LAS unsigned*)(lds + 131072 + 4096 + 16384 + 8448 + ((wave ^ 1) & 7) * 64);
    if (lane == 0) *st.flag_me = 0u;
    __syncthreads();
    { const int q4 = fr >> 2, pp = fr & 3, row = 4 * fq + q4, f = ((2 * row) | (row >> 3)) & 15;
      st.ad0 = (unsigned)(uintptr_t)buf + row * 512 + 16 * ((pp >> 1) ^ f) + 8 * (pp & 1); }
    { const int f = ((2 * fr) | (fr >> 3)) & 15; st.rbase = (unsigned)(uintptr_t)buf + fr * 512 + 16 * (fq ^ f); }
    const float c2 = ATTN_SCALE * 1.4426950408889634f;
    const int hi5 = lane >> 5, p31 = lane & 31;
    const unsigned xsw = 16u * (unsigned)(p31 ^ (2 * hi5));
    const bool xmap = (gridDim.x == 256);
    const int PW = blockIdx.x * 4 + pair, NPW = gridDim.x * 4;
    const int xb = (blockIdx.x & 7) >> 1, lp = (((blockIdx.x & 1) * 32 + (blockIdx.x >> 3)) * 4 + pair);
    const int nq = xmap ? 16 : (NTOK + NPW - 1) / NPW;
    u32x2 iw_cur; bf16x8 BqN[8];
#define HK_DSA_Q(qi_) (xmap ? (xb * 4096 + lp + 256 * (qi_)) : (((PW + NPW * (qi_)) < NTOK) ? (PW + NPW * (qi_)) : NTOK - 1))
    { const int q0_ = HK_DSA_Q(0); iw_cur = *(const u32x2*)(IDX + (size_t)q0_ * 256 + 4 * lane);
      const bf16_t* qp = QL + (size_t)q0_ * 8192 + fr * 512 + 256 * hf + 8 * fq;
#pragma unroll
      for (int ks = 0; ks < 8; ++ks) BqN[ks] = *(const bf16x8*)(qp + 32 * ks); }
    for (int qi = 0; qi < nq; ++qi) {
        const int q = HK_DSA_Q(qi);
        const int b = q >> 12, t = q & 4095;
        st.t = t; st.nsel = t < 255 ? t + 1 : 256;
        asm volatile("s_waitcnt vmcnt(0)" ::: "memory");
        *(HK_LAS u32x2*)(widx + 4 * lane) = iw_cur;
#pragma unroll
        for (int ks = 0; ks < 8; ++ks) st.Bq[ks] = BqN[ks];
        if (qi + 1 < nq) { const int qn = HK_DSA_Q(qi + 1); iw_cur = *(const u32x2*)(IDX + (size_t)qn * 256 + 4 * lane);
            const bf16_t* qp = QL + (size_t)qn * 8192 + fr * 512 + 256 * hf + 8 * fq;
#pragma unroll
            for (int ks = 0; ks < 8; ++ks) BqN[ks] = *(const bf16x8*)(qp + 32 * ks); }
#pragma unroll
        for (int i = 0; i < 16; ++i) st.O[i] = (f32x4){0.f, 0.f, 0.f, 0.f};
        st.mrun = -INFINITY; st.lsum = 0.f;
        const bf16_t* cbase = CKVN + (size_t)(b * 4096) * 512 + 256 * hf;
        asm volatile("s_waitcnt lgkmcnt(0)" ::: "memory");
#define HK_DSA_ISSUE(kt, bi) do { \
            const HK_LAS unsigned short* wl_ = (const HK_LAS unsigned short*)widx + 16 * (kt) + hi5;        \
            unsigned rows_[8]; \
            _Pragma("unroll") for (int i_ = 0; i_ < 8; ++i_) rows_[i_] = wl_[2 * i_]; \
            _Pragma("unroll") for (int i_ = 0; i_ < 8; ++i_) { const unsigned ci_ = ((4u * i_) & 15u) | (i_ >= 4 ? 1u : 0u);        \
                const unsigned off_ = (rows_[i_] << 10) | (xsw ^ (16u * ci_));        \
                __builtin_amdgcn_global_load_lds((const unsigned*)((const char*)cbase + off_), (HK_LAS unsigned*)(buf + 8192 * (bi) + 1024 * i_), 16, 0, 0); } } while (0)
        HK_DSA_ISSUE(0, 0);
#pragma unroll 1
        for (int k2 = 0; k2 < 8; ++k2) {
            HK_DSA_ISSUE(2 * k2 + 1, 1);
            asm volatile("s_waitcnt vmcnt(8)" ::: "memory");
            dsa4_chunk<0>(buf, xs_me, xs_pa, widx, btl, st, 2 * k2, c2);
            if (k2 < 7) { HK_DSA_ISSUE(2 * k2 + 2, 0); asm volatile("s_waitcnt vmcnt(8)" ::: "memory"); }
            else asm volatile("s_waitcnt vmcnt(0)" ::: "memory");
            dsa4_chunk<1>(buf, xs_me, xs_pa, widx, btl, st, 2 * k2 + 1, c2);
        }
#undef HK_DSA_ISSUE
        const float lsum = rows_sum(st.lsum);
        const float inv = 1.0f / lsum;
        bf16_t* op = ((a.pad & 4) ? ((bf16_t*)(ws + WS_VT) + (size_t)PW * 8192) : (QL + (size_t)q * 8192)) + fr * 512 + 256 * hf + 4 * fq;
#pragma unroll
        for (int mt = 0; mt < 16; ++mt) { u32x2 w; w.x = pk2(st.O[mt][0] * inv, st.O[mt][1] * inv); w.y = pk2(st.O[mt][2] * inv, st.O[mt][3] * inv);
            *(u32x2*)(op + 16 * mt) = w; }
        asm volatile("s_waitcnt vmcnt(0) lgkmcnt(0)" ::: "memory");
    }
}

struct MobaSt {
    f32x4 o[2][8]; float mrun[2], lrun[2]; bf16x8 Qf[2][4]; unsigned mymask[2]; int tq[2];
    const bf16_t* ksrc[2]; const bf16_t* vsrc[2];
    int own, ntile, wave1024, fr, fq, wave32, tq0; float b128;
};
template <int S, bool FAR>
HK_DI void moba_scores(const HK_LAS unsigned char* kst, const HK_LAS float* btl, const MobaSt& st, const int s0, const int n, const bool past, const float c2,
                       float (&tmax)[2], float (&ps)[2], float (&tsh)[2], bf16x8 (&Pf)[2][2]) {
    const int fr = st.fr, fq = st.fq;
    f32x4 sa[2][2][2];
#pragma unroll
    for (int kk = 0; kk < 2; ++kk)
#pragma unroll
        for (int m2 = 0; m2 < 2; ++m2) {
            const int mt = 2 * kk + m2;
            bf16x8 Af[4];
#pragma unroll
            for (int ks = 0; ks < 4; ++ks) Af[ks] = *(const HK_LAS bf16x8*)(kst + (16 * mt + fr) * 256 + 16 * ((4 * ks + fq) ^ fr));
#pragma unroll
            for (int g = 0; g < 2; ++g) {
                f32x4 acc = (f32x4){0.f, 0.f, 0.f, 0.f};
#pragma unroll
                for (int ks = 0; ks < 4; ++ks) acc = __builtin_amdgcn_mfma_f32_16x16x32_bf16(Af[ks], st.Qf[g][ks], acc, 0, 0, 0);
                sa[kk][m2][g] = acc; }
        }
    __builtin_amdgcn_sched_barrier(0);
#pragma unroll
    for (int g = 0; g < 2; ++g) {
        const bool mysel = (st.mymask[g] >> n) & 1u;
        const float kc = mysel ? st.b128 - st.mrun[g] : -INFINITY;
#pragma unroll
        for (int kk = 0; kk < 2; ++kk)
#pragma unroll
            for (int m2 = 0; m2 < 2; ++m2) {
                const int mt = 2 * kk + m2; f32x4 acc = sa[kk][m2][g];
                if (FAR) {
                    float e[4];
#pragma unroll
                    for (int j = 0; j < 4; ++j) e[j] = acc[j] * c2 + kc;
                    tsh[g] = __builtin_fmaxf(__builtin_fmaxf(tsh[g], __builtin_fmaxf(e[0], e[1])), __builtin_fmaxf(e[2], e[3]));
#pragma unroll
                    for (int j = 0; j < 4; ++j) { e[j] = __builtin_amdgcn_exp2f(e[j]); acc[j] = e[j]; }
                    ps[g] += (e[0] + e[1]) + (e[2] + e[3]);
                } else {
                    float bv[4]; bool okv[4];
#pragma unroll
                    for (int j = 0; j < 4; ++j) { const int s = s0 + 16 * mt + 4 * fq + j; int d = st.tq[g] - s; okv[j] = past ? mysel : (d >= 0);
                        d = d < 0 ? 0 : (d > 128 ? 128 : d); bv[j] = btl[d]; }
#pragma unroll
                    for (int j = 0; j < 4; ++j) { const float vv = acc[j] * c2 + bv[j]; const float v = okv[j] ? vv : -INFINITY; tmax[g] = fmaxf(tmax[g], v);
                        const float e = __builtin_amdgcn_exp2f(v - st.mrun[g]); acc[j] = e; ps[g] += e; }
                }
                sa[kk][m2][g] = acc; }
    }
#pragma unroll
    for (int kk = 0; kk < 2; ++kk)
#pragma unroll
        for (int g = 0; g < 2; ++g) { const f32x4 p0 = sa[kk][0][g], p1 = sa[kk][1][g];
            u32x4 pw; pw.x = pk2(p0[0], p0[1]); pw.y = pk2(p0[2], p0[3]); pw.z = pk2(p1[0], p1[1]); pw.w = pk2(p1[2], p1[3]);
            Pf[g][kk] = __builtin_bit_cast(bf16x8, pw); }
    __builtin_amdgcn_sched_barrier(0);
}
template <int S>
HK_DI void moba_step(HK_LAS unsigned char* lds, const HK_LAS int* tl, const HK_LAS float* btl, MobaSt& st, const int i) {
    const int fr = st.fr, fq = st.fq;
    if ((S & 1) == 0) {
        asm volatile("s_waitcnt vmcnt(0)" ::: "memory");
        __builtin_amdgcn_s_barrier();
        asm volatile("" ::: "memory");
        if (i + 2 < st.ntile) {
#pragma unroll
            for (int u = 0; u < 2; ++u) {
                const int s0n = tl[1 + i + 2 + u]; HK_LAS unsigned char* stn = lds + ((S + 2 + u) & 3) * 32768 + st.wave1024;
                __builtin_amdgcn_global_load_lds((const unsigned*)(st.ksrc[0] + (size_t)s0n * NP), (HK_LAS unsigned*)(stn), 16, 0, 0);
                __builtin_amdgcn_global_load_lds((const unsigned*)(st.ksrc[1] + (size_t)s0n * NP), (HK_LAS unsigned*)(stn + 8192), 16, 0, 0);
                __builtin_amdgcn_global_load_lds((const unsigned*)(st.vsrc[0] + s0n), (HK_LAS unsigned*)(stn + 16384), 16, 0, 0);
                __builtin_amdgcn_global_load_lds((const unsigned*)(st.vsrc[1] + s0n), (HK_LAS unsigned*)(stn + 16384 + 8192), 16, 0, 0);
            }
        }
    }
    const int s0 = __builtin_amdgcn_readfirstlane(tl[1 + i]);
    const int n = s0 >> 8; const bool past = n < st.own;
    if (!past && (s0 & 255) > st.wave32 + 31) return;
    const HK_LAS unsigned char* kst = lds + S * 32768; const HK_LAS unsigned char* vst = kst + 16384;
    float tmax[2] = {-INFINITY, -INFINITY}, ps[2] = {0.f, 0.f}, tsh[2] = {-INFINITY, -INFINITY};
    const bool far = past && (st.tq0 - (s0 + 63) >= 128);
    const float c2 = ATTN_SCALE * 1.4426950408889634f;
    bf16x8 Pf[2][2];
    if (far) moba_scores<S, true>(kst, btl, st, s0, n, past, c2, tmax, ps, tsh, Pf);
    else moba_scores<S, false>(kst, btl, st, s0, n, past, c2, tmax, ps, tsh, Pf);
#pragma unroll
    for (int kk = 0; kk < 2; ++kk) {
        bf16x8 Vf[8];
#pragma unroll
        for (int md = 0; md < 8; ++md) Vf[md] = *(const HK_LAS bf16x8*)(vst + (16 * md + fr) * 128 + 16 * ((4 * kk + fq) ^ (fr >> 1)));
#pragma unroll
        for (int md = 0; md < 8; ++md) {
            st.o[0][md] = __builtin_amdgcn_mfma_f32_16x16x32_bf16(Vf[md], Pf[0][kk], st.o[0][md], 0, 0, 0);
            st.o[1][md] = __builtin_amdgcn_mfma_f32_16x16x32_bf16(Vf[md], Pf[1][kk], st.o[1][md], 0, 0, 0);
        }
    }
#pragma unroll
    for (int g = 0; g < 2; ++g) {
        st.lrun[g] += ps[g];
        const float tm = rows_max(fmaxf(tmax[g], tsh[g] + st.mrun[g]));
        const bool need = tm > st.mrun[g] + 8.0f;
        if (__ballot(need) != 0ull) {
            const float alpha = need ? __builtin_amdgcn_exp2f(st.mrun[g] - tm) : 1.0f;
            st.mrun[g] = need ? tm : st.mrun[g];
            st.lrun[g] *= alpha;
#pragma unroll
            for (int i2 = 0; i2 < 8; ++i2) st.o[g][i2] *= alpha;
        }
    }
}
HK_DI void phase4_moba(HK_LAS unsigned char* lds, const Args& a) {
    const int tid = threadIdx.x, lane = tid & 63, wave = __builtin_amdgcn_readfirstlane(tid >> 6), fr = lane & 15, fq = lane >> 4;
    unsigned char* ws = a.ws;
    const bf16_t* PROJ = (const bf16_t*)(ws + WS_PROJ); const bf16_t* VT = (const bf16_t*)(ws + WS_VT); const float* KM = (const float*)(ws + WS_KMEAN);
    const float* BT = (const float*)(ws + WS_BT); bf16_t* Y = (bf16_t*)(ws + WS_H);
    HK_LAS float* gates = (HK_LAS float*)lds;
    HK_LAS unsigned* selm = (HK_LAS unsigned*)(lds + 131072);
    HK_LAS int* tl = (HK_LAS int*)(lds + 131072 + 1040);
    HK_LAS float* btl = (HK_LAS float*)(lds + 131072 + 1040 + 336);
    const bool xmap = (gridDim.x == 256);
    for (int it0 = blockIdx.x, rr = 0; it0 < 1024; it0 += gridDim.x, ++rr) {
        int bh, qt;
        if (xmap) { const int lb = blockIdx.x >> 3; bh = (blockIdx.x & 7) + 8 * (2 * rr + (lb >> 4)); qt = (rr & 1) ? 15 - (lb & 15) : (lb & 15); }
        else { bh = it0 & 63; qt = it0 >> 6; }
        const int h = bh & 15, b = bh >> 4, own = qt, t0 = qt * 256;
        const size_t tok0 = (size_t)b * 4096 + t0;
        __syncthreads();
        MobaSt st;
#pragma unroll
        for (int g = 0; g < 2; ++g) { const int ql = 32 * wave + 16 * g + fr; st.tq[g] = t0 + ql;
            const bf16_t* qp = PROJ + (tok0 + ql) * NP + QB_OFF + h * 128 + 8 * fq;
#pragma unroll
            for (int ks = 0; ks < 4; ++ks) st.Qf[g][ks] = *(const bf16x8*)(qp + 32 * ks); }
        { const float* kmr = KM + ((size_t)(b * 16 + fr) * 16 + h) * 128 + 8 * fq;
          bf16x8 Khi[4], Klo[4];
#pragma unroll
          for (int ks = 0; ks < 4; ++ks) { const float4 f0 = *(const float4*)(kmr + 32 * ks), f1 = *(const float4*)(kmr + 32 * ks + 4);
              u32x4 hi, lo; hi.x = pk2(f0.x, f0.y); hi.y = pk2(f0.z, f0.w); hi.z = pk2(f1.x, f1.y); hi.w = pk2(f1.z, f1.w);
              lo.x = pk2(f0.x - bflo(hi.x), f0.y - bfhi(hi.x)); lo.y = pk2(f0.z - bflo(hi.y), f0.w - bfhi(hi.y)); lo.z = pk2(f1.x - bflo(hi.z), f1.y - bfhi(hi.z)); lo.w = pk2(f1.z - bflo(hi.w), f1.w - bfhi(hi.w));
              Khi[ks] = __builtin_bit_cast(bf16x8, hi); Klo[ks] = __builtin_bit_cast(bf16x8, lo); }
#pragma unroll
          for (int g = 0; g < 2; ++g) { f32x4 acc = (f32x4){0.f, 0.f, 0.f, 0.f};
#pragma unroll
              for (int ks = 0; ks < 4; ++ks) { acc = __builtin_amdgcn_mfma_f32_16x16x32_bf16(Khi[ks], st.Qf[g][ks], acc, 0, 0, 0); acc = __builtin_amdgcn_mfma_f32_16x16x32_bf16(Klo[ks], st.Qf[g][ks], acc, 0, 0, 0); }
              *(HK_LAS f32x4*)(gates + (32 * wave + 16 * g + fr) * 16 + 4 * fq) = acc; }
          if (tid == 0) selm[256] = 0u;
          if (tid < 129) { int ti = tid; asm volatile("" : "+v"(ti));
              btl[ti] = BT[(16 + h) * BT_PITCH + ti] * 1.4426950408889634f; } }
        __syncthreads();
        if (tid < 256) {
            float gv[16];
#pragma unroll
            for (int i = 0; i < 4; ++i) { const f32x4 g4 = *(const HK_LAS f32x4*)(gates + tid * 16 + 4 * i); gv[4 * i] = g4[0]; gv[4 * i + 1] = g4[1]; gv[4 * i + 2] = g4[2]; gv[4 * i + 3] = g4[3]; }
            unsigned m = 0u;
#pragma unroll
            for (int r = 0; r < 3; ++r) if (r < own) { float best = -INFINITY; int bi = -1;
#pragma unroll
                for (int n = 0; n < 15; ++n) { const bool free_ = (n < own) && !((m >> n) & 1u); if (free_ && (bi < 0 || gv[n] > best)) { best = gv[n]; bi = n; } }
                if (bi >= 0) m |= 1u << bi; }
            selm[tid] = m; __hip_atomic_fetch_or(&selm[256], m, __ATOMIC_RELAXED, __HIP_MEMORY_SCOPE_WORKGROUP);
        }
        __syncthreads();
        if (tid == 0) { const unsigned um = selm[256]; int c = 0;
            for (int n = 0; n <= own; ++n) if (n == own || ((um >> n) & 1u)) { tl[1 + c] = 256 * n; tl[2 + c] = 256 * n + 64; tl[3 + c] = 256 * n + 128; tl[4 + c] = 256 * n + 192; c += 4; }
            tl[0] = c; }
        __syncthreads();
        st.ntile = __builtin_amdgcn_readfirstlane(tl[0]); st.own = own; st.wave1024 = (wave & 7) * 1024; st.fr = fr; st.fq = fq; st.wave32 = 32 * wave; st.tq0 = t0 + 32 * wave; st.b128 = btl[128];
#pragma unroll
        for (int g = 0; g < 2; ++g) st.mymask[g] = selm[32 * wave + 16 * g + fr];
#pragma unroll
        for (int g = 0; g < 2; ++g) {
#pragma unroll
            for (int i = 0; i < 8; ++i) st.o[g][i] = (f32x4){0.f, 0.f, 0.f, 0.f};
            st.mrun[g] = 0.f; st.lrun[g] = 0.f; }
#pragma unroll
        for (int i = 0; i < 2; ++i) { const int c = tid + 512 * i;
            { const int r = c >> 4, p = c & 15; st.ksrc[i] = PROJ + ((size_t)b * 4096 + r) * NP + KB_OFF + h * 128 + 8 * (p ^ (r & 15)); }
            { const int d = c >> 3, p = c & 7; st.vsrc[i] = VT + ((size_t)bh * 128 + d) * 4096 + 8 * (p ^ ((d >> 1) & 7)); } }
        asm volatile("s_waitcnt vmcnt(0)" ::: "memory");
        __syncthreads();
#pragma unroll
        for (int j = 0; j < 2; ++j) { const int s0_ = tl[1 + j]; HK_LAS unsigned char* st_ = lds + j * 32768 + st.wave1024;
            __builtin_amdgcn_global_load_lds((const unsigned*)(st.ksrc[0] + (size_t)s0_ * NP), (HK_LAS unsigned*)(st_), 16, 0, 0);
            __builtin_amdgcn_global_load_lds((const unsigned*)(st.ksrc[1] + (size_t)s0_ * NP), (HK_LAS unsigned*)(st_ + 8192), 16, 0, 0);
            __builtin_amdgcn_global_load_lds((const unsigned*)(st.vsrc[0] + s0_), (HK_LAS unsigned*)(st_ + 16384), 16, 0, 0);
            __builtin_amdgcn_global_load_lds((const unsigned*)(st.vsrc[1] + s0_), (HK_LAS unsigned*)(st_ + 16384 + 8192), 16, 0, 0); }
        for (int i0 = 0; i0 < st.ntile; i0 += 4) {
            moba_step<0>(lds, tl, btl, st, i0); moba_step<1>(lds, tl, btl, st, i0 + 1); moba_step<2>(lds, tl, btl, st, i0 + 2); moba_step<3>(lds, tl, btl, st, i0 + 3);
        }
#pragma unroll
        for (int g = 0; g < 2; ++g) {
            const float l = rows_sum(st.lrun[g]);
            const float inv = 1.0f / l;
            const size_t tok = tok0 + 32 * wave + 16 * g + fr;
#pragma unroll
            for (int md = 0; md < 8; ++md) { const int col = h * 128 + 16 * md + 4 * fq;
                const u32x2 gz = *(const u32x2*)(PROJ + tok * NP + Z_OFF + 2048 + col);
                u32x2 w; w.x = pk2(st.o[g][md][0] * inv * bflo(gz.x), st.o[g][md][1] * inv * bfhi(gz.x)); w.y = pk2(st.o[g][md][2] * inv * bflo(gz.y), st.o[g][md][3] * inv * bfhi(gz.y));
                *(u32x2*)(Y + tok * DM + 2048 + col) = w; }
        }
    }
    __syncthreads();
}

HK_DI void phase9_conv(const Args& a) {
    unsigned char* ws = a.ws;
    const bf16_t* XRZ = (const bf16_t*)(ws + WS_XRZ); bf16_t* XC = (bf16_t*)(ws + WS_XC);
    const float* cw = a.in[12]; const float* cbias = a.in[13];
    const size_t gtid = (size_t)blockIdx.x * NTHREADS + threadIdx.x, gstride = (size_t)gridDim.x * NTHREADS;
    if (gtid < 256) ((unsigned*)(XC + (size_t)NTOK * DRNN))[gtid] = 0u;
    for (size_t i = gtid; i < (size_t)(NTOK / 16) * 640; i += gstride) {
        const int cg = (int)(i % 640), rc = (int)(i / 640), c0 = cg * 8, row0 = rc * 16, tin = row0 & 4095;
        float w[4][8], bb[8];
#pragma unroll
        for (int j = 0; j < 4; ++j) { const float4 u0 = *(const float4*)(cw + j * DRNN + c0), u1 = *(const float4*)(cw + j * DRNN + c0 + 4);
            w[j][0] = u0.x; w[j][1] = u0.y; w[j][2] = u0.z; w[j][3] = u0.w; w[j][4] = u1.x; w[j][5] = u1.y; w[j][6] = u1.z; w[j][7] = u1.w; }
        { const float4 u0 = *(const float4*)(cbias + c0), u1 = *(const float4*)(cbias + c0 + 4);
          bb[0] = u0.x; bb[1] = u0.y; bb[2] = u0.z; bb[3] = u0.w; bb[4] = u1.x; bb[5] = u1.y; bb[6] = u1.z; bb[7] = u1.w; }
        float x0[8], x1[8], x2[8];
#pragma unroll
        for (int e = 0; e < 8; ++e) { x0[e] = 0.f; x1[e] = 0.f; x2[e] = 0.f; }
        if (tin >= 3) {
            const u32x4 r0 = *(const u32x4*)(XRZ + (size_t)(row0 - 3) * NP2 + c0), r1 = *(const u32x4*)(XRZ + (size_t)(row0 - 2) * NP2 + c0), r2 = *(const u32x4*)(XRZ + (size_t)(row0 - 1) * NP2 + c0);
            x0[0] = bflo(r0.x); x0[1] = bfhi(r0.x); x0[2] = bflo(r0.y); x0[3] = bfhi(r0.y); x0[4] = bflo(r0.z); x0[5] = bfhi(r0.z); x0[6] = bflo(r0.w); x0[7] = bfhi(r0.w);
            x1[0] = bflo(r1.x); x1[1] = bfhi(r1.x); x1[2] = bflo(r1.y); x1[3] = bfhi(r1.y); x1[4] = bflo(r1.z); x1[5] = bfhi(r1.z); x1[6] = bflo(r1.w); x1[7] = bfhi(r1.w);
            x2[0] = bflo(r2.x); x2[1] = bfhi(r2.x); x2[2] = bflo(r2.y); x2[3] = bfhi(r2.y); x2[4] = bflo(r2.z); x2[5] = bfhi(r2.z); x2[6] = bflo(r2.w); x2[7] = bfhi(r2.w);
        }
#pragma unroll
        for (int r = 0; r < 16; ++r) {
            const u32x4 rr = *(const u32x4*)(XRZ + (size_t)(row0 + r) * NP2 + c0);
            const float x3[8] = {bflo(rr.x), bfhi(rr.x), bflo(rr.y), bfhi(rr.y), bflo(rr.z), bfhi(rr.z), bflo(rr.w), bfhi(rr.w)};
            float y[8];
#pragma unroll
            for (int e = 0; e < 8; ++e) y[e] = bb[e] + x0[e] * w[0][e] + x1[e] * w[1][e] + x2[e] * w[2][e] + x3[e] * w[3][e];
            u32x4 ow; ow.x = pk2(y[0], y[1]); ow.y = pk2(y[2], y[3]); ow.z = pk2(y[4], y[5]); ow.w = pk2(y[6], y[7]);
            *(u32x4*)(XC + (size_t)(row0 + r) * DRNN + c0) = ow;
#pragma unroll
            for (int e = 0; e < 8; ++e) { x0[e] = x1[e]; x1[e] = x2[e]; x2[e] = x3[e]; }
        }
    }
}

constexpr int SCAN_CH = 128, SCAN_NCH = SEQ / SCAN_CH;
template <int PASS>
HK_DI void phase_scan(const Args& a) {
    unsigned char* ws = a.ws;
    const bf16_t* LA = (const bf16_t*)(ws + WS_XRZ); const bf16_t* BB = (const bf16_t*)(ws + WS_BB); const bf16_t* SZ = (const bf16_t*)(ws + WS_XRZ) + DRNN;
    bf16_t* Y1 = (bf16_t*)(ws + WS_XC);
    float* CP = (float*)(ws + WS_CARRY); float* CH = CP + (size_t)NBATCH * SCAN_NCH * DRNN;
    const size_t gtid = (size_t)blockIdx.x * NTHREADS + threadIdx.x, gstride = (size_t)gridDim.x * NTHREADS;
    for (size_t i = gtid; i < (size_t)NBATCH * SCAN_NCH * (DRNN / 8); i += gstride) {
        const int co = (int)(i % (DRNN / 8)), bc = (int)(i / (DRNN / 8)), ch = bc % SCAN_NCH, b = bc / SCAN_NCH, c = 8 * co;
        const size_t row0 = (size_t)b * SEQ + (size_t)ch * SCAN_CH;
        float h[8], P[8];
#pragma unroll
        for (int e = 0; e < 8; ++e) { h[e] = 0.f; P[e] = 1.f; }
        if (PASS == 2) {
            for (int k = 0; k < ch; ++k) { const float* pp = CP + ((size_t)(b * SCAN_NCH + k)) * DRNN + c; const float* hh = CH + ((size_t)(b * SCAN_NCH + k)) * DRNN + c;
                const float4 p0 = *(const float4*)pp, p1 = *(const float4*)(pp + 4), h0 = *(const float4*)hh, h1 = *(const float4*)(hh + 4);
                h[0] = p0.x * h[0] + h0.x; h[1] = p0.y * h[1] + h0.y; h[2] = p0.z * h[2] + h0.z; h[3] = p0.w * h[3] + h0.w;
                h[4] = p1.x * h[4] + h1.x; h[5] = p1.y * h[5] + h1.y; h[6] = p1.z * h[6] + h1.z; h[7] = p1.w * h[7] + h1.w; }
        }
#pragma unroll 8
        for (int r = 0; r < SCAN_CH; ++r) {
            const u32x4 lw = *(const u32x4*)(LA + (row0 + r) * NP2 + c), bw = *(const u32x4*)(BB + (row0 + r) * DRNN + c);
            const float la[8] = {bflo(lw.x), bfhi(lw.x), bflo(lw.y), bfhi(lw.y), bflo(lw.z), bfhi(lw.z), bflo(lw.w), bfhi(lw.w)};
            const float bv[8] = {bflo(bw.x), bfhi(bw.x), bflo(bw.y), bfhi(bw.y), bflo(bw.z), bfhi(bw.z), bflo(bw.w), bfhi(bw.w)};
#pragma unroll
            for (int e = 0; e < 8; ++e) { const float av = __expf(la[e]); h[e] = av * h[e] + bv[e]; if (PASS == 1) P[e] *= av; }
            if (PASS == 2) { const u32x4 zw = *(const u32x4*)(SZ + (row0 + r) * NP2 + c);
                u32x4 o; o.x = pk2(h[0] * bflo(zw.x), h[1] * bfhi(zw.x)); o.y = pk2(h[2] * bflo(zw.y), h[3] * bfhi(zw.y)); o.z = pk2(h[4] * bflo(zw.z), h[5] * bfhi(zw.z)); o.w = pk2(h[6] * bflo(zw.w), h[7] * bfhi(zw.w));
                *(u32x4*)(Y1 + (row0 + r) * DRNN + c) = o; }
        }
        if (PASS == 1) { float* pp = CP + (size_t)bc * DRNN + c; float* hh = CH + (size_t)bc * DRNN + c;
            *(float4*)pp = make_float4(P[0], P[1], P[2], P[3]); *(float4*)(pp + 4) = make_float4(P[4], P[5], P[6], P[7]);
            *(float4*)hh = make_float4(h[0], h[1], h[2], h[3]); *(float4*)(hh + 4) = make_float4(h[4], h[5], h[6], h[7]); }
    }
}

HK_DI void phase_final_norm(const Args& a) {
    const int tid = threadIdx.x, lane = tid & 63, wave = tid >> 6;
    const float* g = a.in[2];
    const bf16_t* R = (const bf16_t*)(a.ws + WS_H1);
    for (int row = blockIdx.x * 8 + wave; row < NTOK; row += gridDim.x * 8) {
        float4* xr = (float4*)(a.out + (size_t)row * DM); const u32x2* rr = (const u32x2*)(R + (size_t)row * DM);
        const u32x2* x1r = (const u32x2*)(a.out + (size_t)row * DM + DM / 2);
        float4 v[16]; float ss = 0.f;
#pragma unroll
        for (int i = 0; i < 16; ++i) { const u32x2 w1 = x1r[lane + 64 * i]; const u32x2 w = rr[lane + 64 * i];
            v[i].x = bflo(w1.x) + bflo(w.x); v[i].y = bfhi(w1.x) + bfhi(w.x); v[i].z = bflo(w1.y) + bflo(w.y); v[i].w = bfhi(w1.y) + bfhi(w.y);
            ss += v[i].x * v[i].x + v[i].y * v[i].y + v[i].z * v[i].z + v[i].w * v[i].w; }
        ss = wave_sum(ss);
        const float inv = rsqrtf(ss * (1.0f / DM) + EPS);
#pragma unroll
        for (int i = 0; i < 16; ++i) { const float4 gg = ((const float4*)g)[lane + 64 * i];
            xr[lane + 64 * i] = make_float4(v[i].x * inv * gg.x, v[i].y * inv * gg.y, v[i].z * inv * gg.z, v[i].w * inv * gg.w); }
    }
}

}

#ifndef HK_N_LAUNCHES
#define HK_N_LAUNCHES 1
#endif
constexpr int HK_NPHASES = 15;

__global__ void __launch_bounds__(hk::NTHREADS, 2) hk_fwd(hk::Args args) {
    using namespace hk;
    extern __shared__ __attribute__((aligned(16))) unsigned char lds_raw[];
    HK_LAS unsigned char* lds = (HK_LAS unsigned char*)lds_raw;
    const int tid = threadIdx.x;
    unsigned char* ws = args.ws;
    if (tid < 4) ((HK_LAS unsigned*)(lds + LDS_MISC))[tid] = 0u;
    __syncthreads();
    const int lo = args.ph_lo, hi = args.ph_hi;
    XcdBarrier bar; bar.bar = (unsigned*)(ws + WS_CTL) + args.li * XCD_BAR_WORDS; bar.x = 0; bar.st = nullptr;
    if (hi - lo > 1) bar = xcd_barrier_post((unsigned*)(ws + WS_CTL) + args.li * XCD_BAR_WORDS, (volatile LAS unsigned*)(lds + LDS_MISC));
#ifndef HK_PHASE_MASK
#define HK_PHASE_MASK 0x7fff
#endif
#define HK_IN(k) (((HK_PHASE_MASK >> (k)) & 1) && lo <= (k) && (k) < hi)
#define HK_SEAM(k) do { if (HK_IN(k) && HK_IN((k) + 1)) xcd_barrier(bar); } while (0)

    if (HK_IN(0)) { phase0_prologue(lds, args); HK_SEAM(0); }
    if (HK_IN(1)) {
        { const pg8::Gemm g = mk_gemm((const bf16_t*)(ws + WS_H), (const bf16_t*)(ws + WS_WIN_T), NTOK, 32 * 256, DM);
          pg8::StaticOrder S; S.init(NTOK, 32 * 256, (int)gridDim.x, (int)blockIdx.x);
          EpiBf16Silu E{(bf16_t*)(ws + WS_PROJ), NP, Z_OFF / 256, Z_OFF / 256 + 16, 0};
          pg8::gemm_phase<EpiBf16Silu, pg8::StaticOrder, false>(lds, g, S, E, nullptr); }
        { const pg8::Gemm g = mk_gemm((const bf16_t*)(ws + WS_H), (const bf16_t*)(ws + WS_WIN_T) + (size_t)32 * 256 * DM, NTOK, 27 * 256, DM);
          pg8::StaticOrder S; S.init(NTOK, 27 * 256, (int)gridDim.x, (int)blockIdx.x);
          EpiBf16Silu E{(bf16_t*)(ws + WS_PROJ), NP, Z_OFF / 256, Z_OFF / 256 + 16, 32};
          pg8::gemm_phase<EpiBf16Silu, pg8::StaticOrder, false>(lds, g, S, E, nullptr); }
        HK_SEAM(1);
    }
    if (HK_IN(2)) { phase2_post(lds, args); HK_SEAM(2); }
    if (HK_IN(3)) {
        phase3_indexer(lds, args); __syncthreads();
        {
            const pg8::Gemm g = mk_gemm_b((const bf16_t*)(ws + WS_PROJ) + QA_OFF, (const bf16_t*)(ws + WS_WUK), NTOK, 512, 128, NP, 256, (size_t)128, (size_t)512 * 256, 16);
            pg8::StaticOrder S; S.init(NTOK, 512, (int)gridDim.x, (int)blockIdx.x, 16);
            EpiQlatP E{(bf16_t*)args.out};
            pg8::gemm_phase<EpiQlatP, pg8::StaticOrder, false>(lds, g, S, E, nullptr);
        }
        HK_SEAM(3);
    }
    if (HK_IN(4)) { if (!(args.pad & 1)) { phase4_dsa(lds, args); __syncthreads(); } if (!(args.pad & 2)) phase4_moba(lds, args); HK_SEAM(4); }
    if (HK_IN(5)) {
        const pg8::Gemm g = mk_gemm_b((const bf16_t*)args.out, (const bf16_t*)(ws + WS_WUVT), NTOK, 256, 512, 8192, 512, (size_t)512, (size_t)256 * 512, 16);
        pg8::StaticOrder S; S.init(NTOK, 256, (int)gridDim.x, (int)blockIdx.x, 16);
        EpiOaP E{(bf16_t*)(ws + WS_H), (const bf16_t*)(ws + WS_PROJ)};
        pg8::gemm_phase<EpiOaP, pg8::StaticOrder, false>(lds, g, S, E, nullptr);
        HK_SEAM(5);
    }
    if (HK_IN(6)) {
        const pg8::Gemm g = mk_gemm((const bf16_t*)(ws + WS_H), (const bf16_t*)(ws + WS_WOUT_T), NTOK, DM, DM);
        pg8::StaticOrder S; S.init(NTOK, DM, (int)gridDim.x, (int)blockIdx.x);
        EpiResidStats E{(bf16_t*)args.out + DM, 2 * DM, args.in[0], DM, (float*)(ws + WS_VT)};
        pg8::gemm_phase<EpiResidStats, pg8::StaticOrder, false>(lds, g, S, E, nullptr);
        HK_SEAM(6);
    }
    if (HK_IN(8)) {
        pg8::StaticOrder S; S.init(NTOK, NP2, (int)gridDim.x, (int)blockIdx.x);
        HK_LAS float* rs = (HK_LAS float*)(lds + 131072);
        { int pm0;
          { const int nwg = S.nM * S.nN, wg0 = (int)blockIdx.x % nwg; const int q = nwg / pg8::NXCD, rr = nwg % pg8::NXCD, xcd = wg0 % pg8::NXCD, off = wg0 / pg8::NXCD;
            const int wg = (xcd < rr ? xcd * (q + 1) : rr * (q + 1) + (xcd - rr) * q) + off; const int nig = pg8::WGM * S.nN, fm = (wg / nig) * pg8::WGM, gsz = (S.nM - fm) < pg8::WGM ? (S.nM - fm) : pg8::WGM;
            pm0 = fm + ((wg % nig) % gsz); }
          const int r = tid >> 1, hh = tid & 1; const float4* sp = (const float4*)((const float*)(ws + WS_VT) + (size_t)(pm0 * 256 + r) * 64 + 32 * hh);
          float ssum = 0.f;
#pragma unroll
          for (int i = 0; i < 8; ++i) { const float4 v = sp[i]; ssum += (v.x + v.y) + (v.z + v.w); }
          ssum += __shfl_xor(ssum, 1);
          if (hh == 0) rs[r] = rsqrtf(ssum * (1.0f / DM) + EPS);
          __syncthreads(); }
        const pg8::Gemm g = mk_gemm_b((const bf16_t*)args.out + DM, (const bf16_t*)(ws + WS_RWIN_T), NTOK, NP2, DM, 2 * DM, DM, (size_t)0, (size_t)0, 1);
        EpiBf16SiluRow E{(bf16_t*)(ws + WS_XRZ), NP2, DRNN / 256, NP2 / 256, rs};
        pg8::gemm_phase<EpiBf16SiluRow, pg8::StaticOrder, false>(lds, g, S, E, nullptr);
        HK_SEAM(8);
    }
    if (HK_IN(9)) { phase9_conv(args); HK_SEAM(9); }
    if (HK_IN(10)) {
        const pg8::Gemm g = mk_gemm_b((const bf16_t*)(ws + WS_XC), (const bf16_t*)(ws + WS_WG_T), NTOK, 768, 384, DRNN, 384, (size_t)320, (size_t)768 * 384, 16);
        pg8::StaticOrder S; S.init(NTOK, 768, (int)gridDim.x, (int)blockIdx.x, 16);
        EpiGateP E{(bf16_t*)(ws + WS_XRZ), (bf16_t*)(ws + WS_BB), (const bf16_t*)(ws + WS_XC), args.in[15], args.in[17], (const float*)(ws + WS_LC)};
        pg8::gemm_phase<EpiGateP, pg8::StaticOrder, false>(lds, g, S, E, nullptr);
        HK_SEAM(10);
    }
    if (HK_IN(11)) { phase_scan<1>(args); HK_SEAM(11); }
    if (HK_IN(12)) { phase_scan<2>(args); HK_SEAM(12); }
    if (HK_IN(13)) {
        const pg8::Gemm g = mk_gemm((const bf16_t*)(ws + WS_XC), (const bf16_t*)(ws + WS_RWOUT_T), NTOK, DM, DRNN);
        pg8::StaticOrder S; S.init(NTOK, DM, (int)gridDim.x, (int)blockIdx.x);
        EpiBf16Silu E{(bf16_t*)(ws + WS_H1), DM, 0, 0, 0};
        pg8::gemm_phase<EpiBf16Silu, pg8::StaticOrder, false>(lds, g, S, E, nullptr);
        HK_SEAM(13);
    }
    if (HK_IN(14)) { phase_final_norm(args); }
#undef HK_IN
#undef HK_SEAM
}

extern "C" void kernel_launch(void* const* d_in, const int* in_sizes, int n_in, void* d_out, int out_size, void* d_ws, size_t ws_size, hipStream_t stream) {
    static int grid = 0;
    if (grid == 0) {
        if (n_in != 20 || out_size != hk::NTOK * hk::DM || ws_size < hk::WS_NEED) {
            fprintf(stderr, "kernel_launch: unexpected problem (n_in %d, out %d, ws %zu, need %zu); nothing launched\n", n_in, out_size, ws_size, (size_t)hk::WS_NEED); grid = -1; return; }
        int dev = 0, cus = 0, per_cu = 0;
        if (hipGetDevice(&dev) != hipSuccess || hipDeviceGetAttribute(&cus, hipDeviceAttributeMultiprocessorCount, dev) != hipSuccess) { grid = -1; return; }
        if (hipFuncSetAttribute((const void*)hk_fwd, hipFuncAttributeMaxDynamicSharedMemorySize, hk::LDS_BYTES) != hipSuccess) { fprintf(stderr, "kernel_launch: hipFuncSetAttribute failed\n"); grid = -1; return; }
        if (hipOccupancyMaxActiveBlocksPerMultiprocessor(&per_cu, (const void*)hk_fwd, hk::NTHREADS, hk::LDS_BYTES) != hipSuccess || per_cu < 1)
            fprintf(stderr, "kernel_launch: occupancy query reports %d blocks per CU\n", per_cu);
        (void)hipGetLastError();
        grid = cus >= 64 ? cus - cus % 64 : cus;
    }
    if (grid < 0) return;
    if (hipMemsetAsync((char*)d_ws + hk::WS_CTL, 0, 256 * 1024, stream) != hipSuccess) { fprintf(stderr, "kernel_launch: memset failed\n"); return; }
    hk::Args a{};
    for (int i = 0; i < 20; ++i) a.in[i] = (const float*)d_in[i];
    a.out = (float*)d_out; a.ws = (unsigned char*)d_ws;
#if HK_N_LAUNCHES == 1
#ifdef HK_PROBE_MASK
#ifndef HK_PROBE_P4
#define HK_PROBE_P4 1
#endif
#ifndef HK_PROBE_P3
#define HK_PROBE_P3 0
#endif
#ifndef HK_PROBE_REP
#define HK_PROBE_REP 1
#endif
    { int seg_lo = 0;
      for (int k = 0; k < HK_NPHASES; ++k) if ((HK_PROBE_MASK >> k) & 1) {
          a.ph_lo = seg_lo; a.ph_hi = k + 1; hipLaunchKernelGGL(hk_fwd, dim3(grid), dim3(hk::NTHREADS), hk::LDS_BYTES, stream, a); a.li++;
          a.ph_lo = k; a.ph_hi = k + 1; a.pad = (k == 4) ? HK_PROBE_P4 : (k == 3) ? HK_PROBE_P3 : 0; for (int r_ = 0; r_ < HK_PROBE_REP; ++r_) hipLaunchKernelGGL(hk_fwd, dim3(grid), dim3(hk::NTHREADS), hk::LDS_BYTES, stream, a); a.pad = 0;
          seg_lo = k + 1; }
      if (seg_lo < HK_NPHASES) { a.ph_lo = seg_lo; a.ph_hi = HK_NPHASES; hipLaunchKernelGGL(hk_fwd, dim3(grid), dim3(hk::NTHREADS), hk::LDS_BYTES, stream, a); } }
#else
    a.ph_lo = 0; a.ph_hi = HK_NPHASES;
    hipLaunchKernelGGL(hk_fwd, dim3(grid), dim3(hk::NTHREADS), hk::LDS_BYTES, stream, a);
#endif
#else
    for (int p = 0; p < HK_NPHASES; ++p) { a.ph_lo = p; a.ph_hi = p + 1; hipLaunchKernelGGL(hk_fwd, dim3(grid), dim3(hk::NTHREADS), hk::LDS_BYTES, stream, a); }
#endif
    const hipError_t le = hipPeekAtLastError();
    if (le != hipSuccess) fprintf(stderr, "kernel_launch: launch failed: %s\n", hipGetErrorName(le));
}
```

```cpp
#include <hip/hip_runtime.h>
#include <cstdio>
#include <cstdint>
#define HK_N_LAUNCHES 1
namespace pg8 {
#define PG8_LAS __attribute__((address_space(3)))
typedef unsigned short bf16_t;
typedef short bf16x8 __attribute__((ext_vector_type(8)));
typedef float f32x4 __attribute__((ext_vector_type(4)));
typedef unsigned u32x4 __attribute__((ext_vector_type(4)));
constexpr int BM = 256, BK = 64, HALF = 128, HTB = HALF * BK * 2  , STAGE_BYTES = 8 * HTB, NXCD = 8, WGM = 8;

__host__ __device__ __forceinline__ int lds_byte(int r, int c) { const int st = (r >> 4) * 2 + (c >> 5), rr = r & 15, cc = c & 31, ob = rr * 64 + cc * 2; return st * 1024 + (ob ^ (((ob >> 9) & 1) << 5)); }
__host__ __device__ __forceinline__ void stage_rc(int b, int& R, int& C) { const int st = b / 1024, sb = b % 1024, swz = sb ^ (((sb >> 9) & 1) << 5); R = (st >> 1) * 16 + swz / 64; C = (st & 1) * 32 + (swz % 64) / 2; }
__host__ __device__ __forceinline__ int perm32(int rho) { const int n = rho >> 4, i = rho & 15; return 8 * (i >> 2) + 4 * n + (i & 3); }

struct Unit { int pm, pn, pz; };
struct Gemm { const bf16_t* A; const bf16_t* Bt; int M, N, K; int lda, ldb; size_t za, zb; int nz; };

struct StaticOrder {
    int nM, nN, nwg, G, c, nz;
    __host__ __device__ void init(int M, int N, int G_, int c_, int nz_ = 1) { nM = M / BM; nN = N / BM; nwg = nM * nN; G = G_; c = c_; nz = nz_; }
    __host__ __device__ bool next(int i, Unit& u) const {
        const long L = (long)i * G + c; if (L >= (long)nwg * nz) return false;
        u.pz = (int)(L / nwg); int wgid = (int)(L - (long)u.pz * nwg); { const int q = nwg / NXCD, r = nwg % NXCD, xcd = wgid % NXCD, off = wgid / NXCD; wgid = (xcd < r ? xcd * (q + 1) : r * (q + 1) + (xcd - r) * q) + off; }
        const int nig = WGM * nN, gid = wgid / nig, fm = gid * WGM, gsz = (nM - fm) < WGM ? (nM - fm) : WGM;
        u.pm = fm + ((wgid % nig) % gsz); u.pn = (wgid % nig) / gsz; return true;
    }
    __device__ __forceinline__ void a_ready(const Unit&) const {}
    __device__ __forceinline__ void done(const Unit&) const {}
};
struct CountedOrder : StaticOrder {
    const unsigned* ready; unsigned need; unsigned* tmo;
    __device__ __forceinline__ void a_ready(const Unit& u) const {
        if (threadIdx.x < 64) {
            const unsigned long long t0 = __builtin_amdgcn_s_memrealtime(); unsigned polls = 0;
            while ((unsigned)__builtin_amdgcn_readfirstlane(__hip_atomic_load(ready + 64 * u.pm, __ATOMIC_RELAXED, __HIP_MEMORY_SCOPE_AGENT)) < need) {
                if ((++polls & 255u) == 0u && __builtin_amdgcn_readfirstlane(__hip_atomic_load(tmo, __ATOMIC_RELAXED, __HIP_MEMORY_SCOPE_AGENT)) != 0u) break;
                if (__builtin_amdgcn_s_memrealtime() - t0 > 2000000ull) {
                    if (threadIdx.x == 0) { unsigned expect = 0u; __hip_atomic_compare_exchange_strong(tmo + 1, &expect, 0x600u | (unsigned)(u.pm & 0xff), __ATOMIC_RELAXED, __ATOMIC_RELAXED, __HIP_MEMORY_SCOPE_AGENT); __hip_atomic_store(tmo, 1u, __ATOMIC_RELAXED, __HIP_MEMORY_SCOPE_AGENT); }
                    break; }
                __builtin_amdgcn_s_sleep(2); }
            __builtin_amdgcn_fence(__ATOMIC_ACQUIRE, "agent");
            asm volatile("s_waitcnt vmcnt(0)" ::: "memory");
        }
#if !defined(BROKEN_HOOK_NO_BARRIER)
        asm volatile("" ::: "memory"); __builtin_amdgcn_s_barrier(); asm volatile("" ::: "memory");
#endif
    }
};

__device__ __forceinline__ unsigned cvt_pk_bf16(float lo, float hi) { unsigned r; asm volatile("v_cvt_pk_bf16_f32 %0, %1, %2" : "=v"(r) : "v"(lo), "v"(hi)); return r; }
typedef float f32x2 __attribute__((ext_vector_type(2)));
__device__ __forceinline__ f32x2 gelu_pk(f32x2 v) {
    const f32x2 av = __builtin_elementwise_abs(v), d = av * 0.2316418882f + 1.0f;
    f32x2 t; t.x = __builtin_amdgcn_rcpf(d.x); t.y = __builtin_amdgcn_rcpf(d.y);
    f32x2 q = t * 0.5307027145f + (-0.7265760135f); q = q * t + 0.7107068705f; q = q * t + (-0.142248368f); q = q * t + 0.127414796f; q = q * t;
    const f32x2 s = (v * v) * (-0.72134752044f);
    f32x2 e; e.x = __builtin_amdgcn_exp2f(s.x); e.y = __builtin_amdgcn_exp2f(s.y);
    const f32x2 m = v * (q * e), r = v - m;
    f32x2 o; o.x = v.x < 0.f ? m.x : r.x; o.y = v.y < 0.f ? m.y : r.y; return o;
}

struct EpiF32 {
    static constexpr bool PERM = false, AFTER_DRAIN = false;
    float* C; int ldc; const float* bias;
    __device__ __forceinline__ void operator()(const f32x4 (&acc)[2][2][4][2], const Unit& u, int wr, int wc, int fr, int fq) const {
        const int row0 = u.pm * BM + wr * 64 + fr, col0 = u.pn * BM + wc * 32 + 4 * fq;
        f32x4 bv[2][2];
#pragma unroll
        for (int bj = 0; bj < 2; ++bj)
#pragma unroll
            for (int n = 0; n < 2; ++n) bv[bj][n] = bias ? *(const f32x4*)(bias + col0 + bj * HALF + n * 16) : (f32x4){0.f, 0.f, 0.f, 0.f};
#pragma unroll
        for (int ai = 0; ai < 2; ++ai)
#pragma unroll
            for (int m = 0; m < 4; ++m) { float* rowp = C + (size_t)(row0 + ai * HALF + m * 16) * ldc + col0;
#pragma unroll
                for (int bj = 0; bj < 2; ++bj)
#pragma unroll
                    for (int n = 0; n < 2; ++n) *(f32x4*)(rowp + bj * HALF + n * 16) = acc[ai][bj][m][n] + bv[bj][n]; }
    }
};
template <int ACT  > struct EpiBf16 {
    static constexpr bool PERM = true, AFTER_DRAIN = false;
    bf16_t* O; int ldc; const float* bias; int split_cols; size_t split_stride;
    __device__ __forceinline__ void operator()(const f32x4 (&acc)[2][2][4][2], const Unit& u, int wr, int wc, int fr, int fq) const {
        const int row0 = u.pm * BM + wr * 64 + fr; int colt = u.pn * BM; bf16_t* base = O;
        if (split_cols) { const int t = colt / split_cols; base += (size_t)t * split_stride; colt -= t * split_cols; }
        const int col0 = colt + wc * 32 + 8 * fq, bcol0 = u.pn * BM + wc * 32 + 8 * fq;
        f32x4 bv[2][2];
#pragma unroll
        for (int bj = 0; bj < 2; ++bj)
#pragma unroll
            for (int n = 0; n < 2; ++n) bv[bj][n] = bias ? *(const f32x4*)(bias + bcol0 + bj * HALF + 4 * n) : (f32x4){0.f, 0.f, 0.f, 0.f};
#pragma unroll
        for (int ai = 0; ai < 2; ++ai)
#pragma unroll
            for (int m = 0; m < 4; ++m) { bf16_t* rowp = base + (size_t)(row0 + ai * HALF + m * 16) * ldc + col0;
#pragma unroll
                for (int bj = 0; bj < 2; ++bj) { f32x4 v0 = acc[ai][bj][m][0] + bv[bj][0], v1 = acc[ai][bj][m][1] + bv[bj][1];
                    if (ACT == 1) { f32x2 a = gelu_pk((f32x2){v0[0], v0[1]}), b = gelu_pk((f32x2){v0[2], v0[3]}), c = gelu_pk((f32x2){v1[0], v1[1]}), d = gelu_pk((f32x2){v1[2], v1[3]});
                        v0 = (f32x4){a.x, a.y, b.x, b.y}; v1 = (f32x4){c.x, c.y, d.x, d.y}; }
                    if (ACT == 2) {
#pragma unroll
                        for (int j = 0; j < 4; ++j) { v0[j] = 0.5f * v0[j] * (1.0f + erff(v0[j] * 0.70710678f)); v1[j] = 0.5f * v1[j] * (1.0f + erff(v1[j] * 0.70710678f)); } }
                    u32x4 w; w.x = cvt_pk_bf16(v0[0], v0[1]); w.y = cvt_pk_bf16(v0[2], v0[3]); w.z = cvt_pk_bf16(v1[0], v1[1]); w.w = cvt_pk_bf16(v1[2], v1[3]);
                    *(u32x4*)(rowp + bj * HALF) = w; } }
    }
};

template <class Epi, class Sched, bool STAMP = false>
__device__ __forceinline__ void gemm_phase(PG8_LAS unsigned char* lds, const Gemm g, const Sched& S, const Epi& E, unsigned long long* stamps) {
    const int tid = threadIdx.x, wid = __builtin_amdgcn_readfirstlane(tid >> 6), lane = tid & 63, wr = wid >> 2, wc = wid & 3, fr = lane & 15, fq = lane >> 4;
    const int K = g.K, nt = K / BK;
    int ts_lo = 0, ts_hi = 0, nts = 0; const unsigned long long rt_entry = STAMP ? (unsigned long long)wall_clock64() : 0ull;
#define PG8_STAMP() do { if (STAMP && wid == 0 && nts < 64) { const unsigned long long _c = (unsigned long long)clock64(); \
        ts_lo = (lane == nts) ? (int)(unsigned)_c : ts_lo; ts_hi = (lane == nts) ? (int)(unsigned)(_c >> 32) : ts_hi; ++nts; } } while (0)
    PG8_STAMP();
    unsigned voffA[2], voffB[2];
#pragma unroll
    for (int i = 0; i < 2; ++i) { int R, C; stage_rc(tid * 16 + i * 8192, R, C); const int Rb = Epi::PERM ? ((R & ~31) + perm32(R & 31)) : R;
        voffA[i] = (unsigned)(R * g.lda + C) * 2u; voffB[i] = (unsigned)(Rb * g.ldb + C) * 2u; }
    const size_t kstep = (size_t)(BK * 2);
    const size_t hstepA = (size_t)HALF * g.lda * 2, hstepB = (size_t)HALF * g.ldb * 2;
    const size_t tstepA = 2 * hstepA, tstepB = 2 * hstepB;
    const unsigned ldsw = (unsigned)wid * 1024u;
    const int aoff = lds_byte(wr * 64 + fr, fq * 8), boff = lds_byte(wc * 32 + fr, fq * 8);
#define PG8_SA(b, h) (((b) * 2 + (h)) * HTB)
#define PG8_SB(b, h) ((4 + (b) * 2 + (h)) * HTB)
#define PG8_STAGE(bufoff, gbase, voff) do { _Pragma("unroll") for (int _i = 0; _i < 2; ++_i) \
        __builtin_amdgcn_global_load_lds((const unsigned*)((const char*)(gbase) + (voff)[_i]), (PG8_LAS unsigned*)(lds + (bufoff) + ldsw + _i * 8192), 16, 0, 0); } while (0)
#define PG8_LDA(dst, b, h) do { _Pragma("unroll") for (int m = 0; m < 4; ++m) _Pragma("unroll") for (int k = 0; k < 2; ++k) dst[m][k] = *(const PG8_LAS bf16x8*)(lds + PG8_SA(b, h) + aoff + m * 2048 + k * 1024); } while (0)
#define PG8_LDB(dst, b, h) do { _Pragma("unroll") for (int n = 0; n < 2; ++n) _Pragma("unroll") for (int k = 0; k < 2; ++k) dst[n][k] = *(const PG8_LAS bf16x8*)(lds + PG8_SB(b, h) + boff + n * 2048 + k * 1024); } while (0)
#define PG8_MMA(ai, bj, At, Bt) do { __builtin_amdgcn_s_setprio(1); _Pragma("unroll") for (int m = 0; m < 4; ++m) _Pragma("unroll") for (int n = 0; n < 2; ++n) _Pragma("unroll") for (int k = 0; k < 2; ++k) \
        acc[ai][bj][m][n] = __builtin_amdgcn_mfma_f32_16x16x32_bf16(Bt[n][k], At[m][k], acc[ai][bj][m][n], 0, 0, 0); __builtin_amdgcn_s_setprio(0); } while (0)
#define PG8_WAIT_V(n) asm volatile("s_waitcnt vmcnt(" #n ")" ::: "memory")
#define PG8_WAIT_L(n) asm volatile("s_waitcnt lgkmcnt(" #n ")" ::: "memory")
#define PG8_BAR __builtin_amdgcn_s_barrier()
#define PG8_SCHED __builtin_amdgcn_sched_barrier(0)
    Unit cur, nxt; int ui = 0;
    if (!S.next(0, cur)) return;
    f32x4 acc[2][2][4][2];
#pragma unroll
    for (int a = 0; a < 2; ++a)
#pragma unroll
        for (int b = 0; b < 2; ++b)
#pragma unroll
            for (int m = 0; m < 4; ++m)
#pragma unroll
                for (int n = 0; n < 2; ++n) acc[a][b][m][n] = (f32x4){0.f, 0.f, 0.f, 0.f};
    bf16x8 At[4][2], B0[2][2], B1[2][2];
    const char* cA = (const char*)(g.A + (size_t)cur.pz * g.za) + (size_t)cur.pm * tstepA; const char* cB = (const char*)(g.Bt + (size_t)cur.pz * g.zb) + (size_t)cur.pn * tstepB;
    S.a_ready(cur);
    PG8_STAGE(PG8_SB(0, 0), cB, voffB); PG8_STAGE(PG8_SA(0, 0), cA, voffA); PG8_STAGE(PG8_SB(0, 1), cB + hstepB, voffB); PG8_STAGE(PG8_SA(0, 1), cA + hstepA, voffA);
    if (wr == 1) PG8_BAR;
    PG8_WAIT_V(4); PG8_BAR;
    PG8_STAGE(PG8_SB(1, 0), cB + kstep, voffB); PG8_STAGE(PG8_SA(1, 0), cA + kstep, voffA); PG8_STAGE(PG8_SB(1, 1), cB + hstepB + kstep, voffB);
    PG8_WAIT_V(6); PG8_BAR;
    PG8_STAMP();
    for (;;) {
        const bool has_next = S.next(ui + 1, nxt);
        const char* nA = has_next ? (const char*)(g.A + (size_t)nxt.pz * g.za) + (size_t)nxt.pm * tstepA : cA; const char* nB = has_next ? (const char*)(g.Bt + (size_t)nxt.pz * g.zb) + (size_t)nxt.pn * tstepB : cB;
        for (int t = 0; t < nt; t += 2) {
            const bool last = (t == nt - 2);
            const char* a1 = cA + (size_t)(t + 1) * kstep;
            const char* a2 = last ? nA : cA + (size_t)(t + 2) * kstep; const char* b2 = last ? nB : cB + (size_t)(t + 2) * kstep;
            const char* a3 = a2 + kstep; const char* b3 = b2 + kstep;
            if (last && has_next) S.a_ready(nxt);
            PG8_LDB(B0, 0, 0); PG8_SCHED; PG8_LDA(At, 0, 0); PG8_STAGE(PG8_SA(1, 1), a1 + hstepA, voffA);
            PG8_WAIT_L(8); PG8_BAR; PG8_WAIT_L(0); PG8_MMA(0, 0, At, B0); PG8_BAR; PG8_SCHED;
            PG8_LDB(B1, 0, 1); PG8_STAGE(PG8_SB(0, 0), b2, voffB);
            PG8_BAR; PG8_WAIT_L(0); PG8_MMA(0, 1, At, B1); PG8_BAR;
            PG8_LDA(At, 0, 1); PG8_STAGE(PG8_SA(0, 0), a2, voffA);
            PG8_BAR; PG8_WAIT_L(0); PG8_MMA(1, 0, At, B0); PG8_BAR; PG8_SCHED;
            PG8_STAGE(PG8_SB(0, 1), b2 + hstepB, voffB);
            PG8_WAIT_V(6); PG8_BAR; PG8_MMA(1, 1, At, B1); PG8_BAR;
            PG8_LDB(B0, 1, 0); PG8_SCHED; PG8_LDA(At, 1, 0); PG8_STAGE(PG8_SA(0, 1), a2 + hstepA, voffA);
            PG8_WAIT_L(8); PG8_BAR; PG8_WAIT_L(0); PG8_MMA(0, 0, At, B0); PG8_BAR; PG8_SCHED;
            PG8_LDB(B1, 1, 1); PG8_STAGE(PG8_SB(1, 0), b3, voffB);
            PG8_BAR; PG8_WAIT_L(0); PG8_MMA(0, 1, At, B1); PG8_BAR;
            PG8_LDA(At, 1, 1); PG8_STAGE(PG8_SA(1, 0), a3, voffA);
            PG8_BAR; PG8_WAIT_L(0); PG8_MMA(1, 0, At, B0); PG8_BAR; PG8_SCHED;
            PG8_STAGE(PG8_SB(1, 1), b3 + hstepB, voffB);
            PG8_WAIT_V(6); PG8_BAR; PG8_MMA(1, 1, At, B1); PG8_BAR;
        }
        PG8_STAMP();
        if constexpr (!Epi::AFTER_DRAIN) { E(acc, cur, wr, wc, fr, fq); S.done(cur); }
        PG8_STAMP();
        if (!has_next) break;
#pragma unroll
        for (int a = 0; a < 2; ++a)
#pragma unroll
            for (int b = 0; b < 2; ++b)
#pragma unroll
                for (int m = 0; m < 4; ++m)
#pragma unroll
                    for (int n = 0; n < 2; ++n) acc[a][b][m][n] = (f32x4){0.f, 0.f, 0.f, 0.f};
        cur = nxt; cA = nA; cB = nB; ++ui;
    }
    PG8_WAIT_V(0);
    if (wr == 0) PG8_BAR;
    PG8_BAR;
    if constexpr (Epi::AFTER_DRAIN) { E.fused(acc, cur, wr, wc, fr, fq, lds, wid, lane); S.done(cur); }
    PG8_STAMP();
    if (STAMP && wid == 0) { stamps[lane] = lane < nts ? (((unsigned long long)(unsigned)ts_hi << 32) | (unsigned)ts_lo) : 0ull;
        if (lane == 62) stamps[62] = rt_entry; if (lane == 63) stamps[63] = (unsigned long long)wall_clock64(); }
#undef PG8_STAMP
#undef PG8_SA
#undef PG8_SB
#undef PG8_STAGE
#undef PG8_LDA
#undef PG8_LDB
#undef PG8_MMA
#undef PG8_WAIT_V
#undef PG8_WAIT_L
#undef PG8_BAR
#undef PG8_SCHED
}
}

#define XB_TMO      128
#define XB_XCNT(j)  (256  + 64 * (j))
#define XB_XSUB(j)  (1280 + 64 * (j))
#define XB_XGEN(j)  (2304 + 64 * (j))
#define XB_TOP      3328
#define XB_TOPGEN   3392
#define XCD_BAR_WORDS 3456
#define XB_SPIN_CAP (1u << 18)
#define LAS __attribute__((address_space(3)))

__device__ __forceinline__ unsigned xb_ld(unsigned* p)              { return __hip_atomic_load(p, __ATOMIC_RELAXED, __HIP_MEMORY_SCOPE_AGENT); }
__device__ __forceinline__ unsigned xb_add(unsigned* p, unsigned v) { return __hip_atomic_fetch_add(p, v, __ATOMIC_RELAXED, __HIP_MEMORY_SCOPE_AGENT); }
__device__ __forceinline__ unsigned xb_xcc_id() { return (unsigned)__builtin_amdgcn_s_getreg((3 << 11) | 20) & 0xFu; }
#define XB_SPIN(cond, bar) do { unsigned _sp = 0; while (cond) { __builtin_amdgcn_s_sleep(1); \
    if ((++_sp & 255u) == 0u) { if (xb_ld(&(bar)[XB_TMO])) break; if (_sp > XB_SPIN_CAP) { atomicAdd(&(bar)[XB_TMO], 1u); break; } } } } while (0)

struct XcdBarrier {
    unsigned* bar; unsigned x;
    volatile LAS unsigned* st;
};

__device__ __forceinline__ XcdBarrier xcd_barrier_post(unsigned* bar, volatile LAS unsigned* st) {
    XcdBarrier b; b.bar = bar; b.x = xb_xcc_id(); b.st = st;
    if (threadIdx.x == 0) (void)xb_add(&bar[XB_XCNT(b.x)], 1u);
    return b;
}
__device__ __forceinline__ void xcd_barrier_complete(unsigned* bar, unsigned x, unsigned& nloc, unsigned& nx) {
    const unsigned G = gridDim.x * gridDim.y * gridDim.z;
    unsigned sum, cnt, mine, sp = 0u;
    for (;;) {
        sum = 0u; cnt = 0u; mine = 0u;
#pragma unroll
        for (unsigned j = 0; j < 16; ++j) { const unsigned c = xb_ld(&bar[XB_XCNT(j)]); sum += c; cnt += (c > 0u) ? 1u : 0u; mine = (j == x) ? c : mine; }
        if (sum == G) break;
        __builtin_amdgcn_s_sleep(1);
        if ((++sp & 255u) == 0u) { if (xb_ld(&bar[XB_TMO])) break; if (sp > XB_SPIN_CAP) { atomicAdd(&bar[XB_TMO], 1u); break; } }
    }
    nloc = mine > 0u ? mine : 1u; nx = cnt > 0u ? cnt : 1u;
}

__device__ __forceinline__ void xcd_barrier(const XcdBarrier& b) {
    asm volatile("s_waitcnt vmcnt(0)" ::: "memory");
    __syncthreads();
    if (threadIdx.x == 0) {
        unsigned* bar = b.bar;
        __builtin_amdgcn_s_waitcnt(0);
        unsigned nloc = b.st[0], nx = b.st[1];
        if (nloc == 0u) { xcd_barrier_complete(bar, b.x, nloc, nx); b.st[0] = nloc; b.st[1] = nx; }
        const unsigned old = xb_add(&bar[XB_XSUB(b.x)], 1u);
        const unsigned gen = old / nloc;
        if (old + 1u == (gen + 1u) * nloc) {
            __builtin_amdgcn_fence(__ATOMIC_RELEASE, "agent");
            asm volatile("s_waitcnt vmcnt(0)" ::: "memory");
            const unsigned og = xb_add(&bar[XB_TOP], 1u);
            const unsigned tg = og / nx;
            if (og + 1u == (tg + 1u) * nx) xb_add(&bar[XB_TOPGEN], 1u);
            else XB_SPIN(xb_ld(&bar[XB_TOPGEN]) == tg, bar);
            __builtin_amdgcn_fence(__ATOMIC_ACQUIRE, "agent");
            xb_add(&bar[XB_XGEN(b.x)], 1u);
            asm volatile("s_waitcnt vmcnt(0)" ::: "memory");
        } else {
            XB_SPIN(xb_ld(&bar[XB_XGEN(b.x)]) == gen, bar);
            __builtin_amdgcn_fence(__ATOMIC_ACQUIRE, "agent");
            asm volatile("s_waitcnt vmcnt(0)" ::: "memory");
        }
    }
    __syncthreads();
}

namespace hk {
typedef unsigned short bf16_t;
typedef short bf16x8 __attribute__((ext_vector_type(8)));
typedef short bf16x4 __attribute__((ext_vector_type(4)));
typedef float f32x4 __attribute__((ext_vector_type(4)));
typedef float f32x16 __attribute__((ext_vector_type(16)));
typedef unsigned u32x4 __attribute__((ext_vector_type(4)));
typedef unsigned u32x2 __attribute__((ext_vector_type(2)));
#define HK_LAS __attribute__((address_space(3)))
#define HK_DI __device__ __forceinline__

constexpr int NTOK = 16384, DM = 4096, SEQ = 4096, NBATCH = 4;
constexpr int NP = 15104;
constexpr int QA_OFF = 0, CKV_OFF = 2048, QI_OFF = 2560, QB_OFF = 4608, KB_OFF = 6656, VB_OFF = 8704, Z_OFF = 10752, KI_OFF = 14848, WI_OFF = 14912;
constexpr int DRNN = 5120, NP2 = 10240;
constexpr int NTHREADS = 512;
constexpr int LDS_BYTES = 160 * 1024;
constexpr int LDS_MISC = 159 * 1024;
constexpr int BT_PITCH = 132;
constexpr float ATTN_SCALE = 0.08838834764831845f;
constexpr float EPS = 1e-6f;

constexpr size_t WS_CTL = 0;
constexpr size_t WS_BT = 256 * 1024;
constexpr size_t WS_LC = 288 * 1024;
constexpr size_t WS_KMEAN = 320 * 1024;
constexpr size_t WS_CARRY = 1024 * 1024;
constexpr size_t WS_RWIN_T = 8ull * 1024 * 1024;
constexpr size_t WS_RWOUT_T = WS_RWIN_T + 10240ull * 4096 * 2;
constexpr size_t WS_WG_T = WS_RWOUT_T + 4096ull * 5120 * 2;
constexpr size_t WS_L0 = WS_WG_T + 16ull * 768 * 384 * 2;
constexpr size_t WS_WIN_T = WS_L0;
constexpr size_t WS_WOUT_T = WS_WIN_T + 15104ull * 4096 * 2;
constexpr size_t WS_WUK = WS_WOUT_T + 4096ull * 4096 * 2;
constexpr size_t WS_WUVT = WS_WUK + 16ull * 512 * 256 * 2;
constexpr size_t WS_H = WS_WUVT + 16ull * 256 * 512 * 2;
constexpr size_t WS_PROJ = WS_H + 16384ull * 4096 * 2;
constexpr size_t WS_IDX = WS_PROJ + 16384ull * NP * 2;
constexpr size_t WS_CKVN = WS_IDX + 16384ull * 256 * 2;
constexpr size_t WS_KIN = WS_CKVN + 16384ull * 512 * 2;
constexpr size_t WS_WI = WS_KIN + 16384ull * 64 * 2;
constexpr size_t WS_VT = WS_WI + 16384ull * 32 * 4;
constexpr size_t WS_END0 = WS_VT + 4ull * 16 * 128 * 4096 * 2;
constexpr size_t WS_H1 = WS_L0;
constexpr size_t WS_XRZ = WS_H1 + 16384ull * 4096 * 2;
constexpr size_t WS_XC = WS_XRZ + 16384ull * NP2 * 2;
constexpr size_t WS_BB = WS_XC + 16384ull * DRNN * 2 + 4096;
constexpr size_t WS_CARRY2 = WS_BB + 16384ull * DRNN * 2;
constexpr size_t WS_END1 = WS_CARRY2 + 2ull * 4 * 64 * 5120 * 4;
constexpr size_t WS_NEED = WS_END0 > WS_END1 ? WS_END0 : WS_END1;

HK_DI float bf2f(unsigned short b) { return __uint_as_float(((unsigned)b) << 16); }
HK_DI float bflo(unsigned u) { return __uint_as_float(u << 16); }
HK_DI float bfhi(unsigned u) { return __uint_as_float(u & 0xffff0000u); }
typedef __bf16 hk_bf2 __attribute__((ext_vector_type(2)));
typedef float hk_f2 __attribute__((ext_vector_type(2)));
HK_DI unsigned pk2(float lo, float hi) { const hk_f2 v = {lo, hi}; const hk_bf2 r = __builtin_convertvector(v, hk_bf2); return __builtin_bit_cast(unsigned, r); }
HK_DI unsigned short f2bf(float f) { return (unsigned short)(pk2(f, 0.f) & 0xffffu); }
HK_DI float silu_f(float v) { return v * __builtin_amdgcn_rcpf(1.0f + __expf(-v)); }
HK_DI float sigmoid_f(float v) { return __builtin_amdgcn_rcpf(1.0f + __expf(-v)); }
HK_DI float wave_sum(float v) {
#pragma unroll
    for (int o = 32; o >= 1; o >>= 1) v += __shfl_xor(v, o);
    return v;
}
HK_DI float rows_max(float x) {
    auto r = __builtin_amdgcn_permlane16_swap(__float_as_uint(x), __float_as_uint(x), false, false); x = fmaxf(__uint_as_float(r[0]), __uint_as_float(r[1]));
    r = __builtin_amdgcn_permlane32_swap(__float_as_uint(x), __float_as_uint(x), false, false); return fmaxf(__uint_as_float(r[0]), __uint_as_float(r[1]));
}
HK_DI float rows_sum(float x) {
    auto r = __builtin_amdgcn_permlane16_swap(__float_as_uint(x), __float_as_uint(x), false, false); x = __uint_as_float(r[0]) + __uint_as_float(r[1]);
    r = __builtin_amdgcn_permlane32_swap(__float_as_uint(x), __float_as_uint(x), false, false); return __uint_as_float(r[0]) + __uint_as_float(r[1]);
}
HK_DI int t5_bucket(int d) {
    if (d < 16) return d;
    int b = 16;
    b += d >= 19; b += d >= 21; b += d >= 24; b += d >= 27; b += d >= 31; b += d >= 35; b += d >= 40; b += d >= 46;
    b += d >= 52; b += d >= 59; b += d >= 67; b += d >= 77; b += d >= 87; b += d >= 99; b += d >= 113;
    return b;
}

struct Args { const float* in[20]; float* out; unsigned char* ws; int ph_lo, ph_hi, li, pad; };

struct EpiBf16Silu {
    static constexpr bool PERM = true, AFTER_DRAIN = false;
    bf16_t* O; int ldc; int silu_lo, silu_hi; int pn0;
    __device__ __forceinline__ void operator()(const pg8::f32x4 (&acc)[2][2][4][2], const pg8::Unit& u, int wr, int wc, int fr, int fq) const {
        const int pn = u.pn + pn0;
        const int row0 = u.pm * 256 + wr * 64 + fr; const int col0 = pn * 256 + wc * 32 + 8 * fq;
        const bool act = (pn >= silu_lo) && (pn < silu_hi);
#pragma unroll
        for (int ai = 0; ai < 2; ++ai)
#pragma unroll
            for (int m = 0; m < 4; ++m) { bf16_t* rowp = O + (size_t)(row0 + ai * 128 + m * 16) * ldc + col0;
#pragma unroll
                for (int bj = 0; bj < 2; ++bj) { pg8::f32x4 v0 = acc[ai][bj][m][0], v1 = acc[ai][bj][m][1];
                    if (act) {
#pragma unroll
                        for (int j = 0; j < 4; ++j) { v0[j] = silu_f(v0[j]); v1[j] = silu_f(v1[j]); } }
                    u32x4 w; w.x = pk2(v0[0], v0[1]); w.y = pk2(v0[2], v0[3]); w.z = pk2(v1[0], v1[1]); w.w = pk2(v1[2], v1[3]);
                    __builtin_nontemporal_store(w, (u32x4*)(rowp + bj * 128));   } }
    }
};
struct EpiResidStats {
    static constexpr bool PERM = true, AFTER_DRAIN = false;
    bf16_t* O; int ldc; const float* R; int ldr; float* ST;
    __device__ __forceinline__ void operator()(const pg8::f32x4 (&acc)[2][2][4][2], const pg8::Unit& u, int wr, int wc, int fr, int fq) const {
        const int row0 = u.pm * 256 + wr * 64 + fr; const int col0 = u.pn * 256 + wc * 32 + 8 * fq;
#pragma unroll
        for (int ai = 0; ai < 2; ++ai)
#pragma unroll
            for (int m = 0; m < 4; ++m) { const int row = row0 + ai * 128 + m * 16; bf16_t* rowp = O + (size_t)row * ldc + col0; float ss = 0.f;
#pragma unroll
                for (int bj = 0; bj < 2; ++bj) { pg8::f32x4 v0 = acc[ai][bj][m][0], v1 = acc[ai][bj][m][1];
                    const float4* rp = (const float4*)(R + (size_t)row * ldr + col0 + bj * 128); const float4 r0 = rp[0], r1 = rp[1];
                    v0[0] += r0.x; v0[1] += r0.y; v0[2] += r0.z; v0[3] += r0.w; v1[0] += r1.x; v1[1] += r1.y; v1[2] += r1.z; v1[3] += r1.w;
                    ss += (v0[0] * v0[0] + v0[1] * v0[1]) + (v0[2] * v0[2] + v0[3] * v0[3]) + (v1[0] * v1[0] + v1[1] * v1[1]) + (v1[2] * v1[2] + v1[3] * v1[3]);
                    u32x4 w; w.x = pk2(v0[0], v0[1]); w.y = pk2(v0[2], v0[3]); w.z = pk2(v1[0], v1[1]); w.w = pk2(v1[2], v1[3]);
                    __builtin_nontemporal_store(w, (u32x4*)(rowp + bj * 128));   }
                ss = rows_sum(ss);
                if (fq == 0) ST[(size_t)row * 64 + 4 * u.pn + wc] = ss; }
    }
};
struct EpiBf16SiluRow {
    static constexpr bool PERM = true, AFTER_DRAIN = false;
    bf16_t* O; int ldc; int silu_lo, silu_hi; const HK_LAS float* rs;
    __device__ __forceinline__ void operator()(const pg8::f32x4 (&acc)[2][2][4][2], const pg8::Unit& u, int wr, int wc, int fr, int fq) const {
        const int rl0 = wr * 64 + fr; const int col0 = u.pn * 256 + wc * 32 + 8 * fq;
        const bool act = (u.pn >= silu_lo) && (u.pn < silu_hi);
#pragma unroll
        for (int ai = 0; ai < 2; ++ai)
#pragma unroll
            for (int m = 0; m < 4; ++m) { const int rl = rl0 + ai * 128 + m * 16; const float sc = rs[rl]; bf16_t* rowp = O + (size_t)(u.pm * 256 + rl) * ldc + col0;
#pragma unroll
                for (int bj = 0; bj < 2; ++bj) { pg8::f32x4 v0 = acc[ai][bj][m][0] * sc, v1 = acc[ai][bj][m][1] * sc;
                    if (act) {
#pragma unroll
                        for (int j = 0; j < 4; ++j) { v0[j] = silu_f(v0[j]); v1[j] = silu_f(v1[j]); } }
                    u32x4 w; w.x = pk2(v0[0], v0[1]); w.y = pk2(v0[2], v0[3]); w.z = pk2(v1[0], v1[1]); w.w = pk2(v1[2], v1[3]);
                    __builtin_nontemporal_store(w, (u32x4*)(rowp + bj * 128)); } }
    }
};
HK_DI pg8::Gemm mk_gemm(const bf16_t* A, const bf16_t* Bt, int M, int N, int K) { pg8::Gemm g; g.A = A; g.Bt = Bt; g.M = M; g.N = N; g.K = K; g.lda = K; g.ldb = K; g.za = 0; g.zb = 0; g.nz = 1; return g; }
HK_DI pg8::Gemm mk_gemm_b(const bf16_t* A, const bf16_t* Bt, int M, int N, int K, int lda, int ldb, size_t za, size_t zb, int nz) { pg8::Gemm g; g.A = A; g.Bt = Bt; g.M = M; g.N = N; g.K = K; g.lda = lda; g.ldb = ldb; g.za = za; g.zb = zb; g.nz = nz; return g; }
struct EpiQlatP {
    static constexpr bool PERM = true, AFTER_DRAIN = false;
    bf16_t* Q;
    __device__ __forceinline__ void operator()(const pg8::f32x4 (&acc)[2][2][4][2], const pg8::Unit& u, int wr, int wc, int fr, int fq) const {
        const int row0 = u.pm * 256 + wr * 64 + fr; const int col0 = u.pz * 512 + u.pn * 256 + wc * 32 + 8 * fq;
#pragma unroll
        for (int ai = 0; ai < 2; ++ai)
#pragma unroll
            for (int m = 0; m < 4; ++m) { bf16_t* rowp = Q + (size_t)(row0 + ai * 128 + m * 16) * 8192 + col0;
#pragma unroll
                for (int bj = 0; bj < 2; ++bj) { const pg8::f32x4 v0 = acc[ai][bj][m][0], v1 = acc[ai][bj][m][1];
                    u32x4 w; w.x = pk2(v0[0], v0[1]); w.y = pk2(v0[2], v0[3]); w.z = pk2(v1[0], v1[1]); w.w = pk2(v1[2], v1[3]);
                    *(u32x4*)(rowp + bj * 128) = w; } }
    }
};
struct EpiOaP {
    static constexpr bool PERM = true, AFTER_DRAIN = false;
    bf16_t* Y; const bf16_t* PROJ;
    __device__ __forceinline__ void operator()(const pg8::f32x4 (&acc)[2][2][4][2], const pg8::Unit& u, int wr, int wc, int fr, int fq) const {
        const int row0 = u.pm * 256 + wr * 64 + fr; const int col0 = u.pz * 128 + wc * 32 + 8 * fq;
#pragma unroll
        for (int ai = 0; ai < 2; ++ai)
#pragma unroll
            for (int m = 0; m < 4; ++m) { const size_t row = (size_t)(row0 + ai * 128 + m * 16);
                const u32x4 g = *(const u32x4*)(PROJ + row * NP + Z_OFF + col0);
                const pg8::f32x4 v0 = acc[ai][0][m][0], v1 = acc[ai][0][m][1];
                u32x4 w; w.x = pk2(v0[0] * bflo(g.x), v0[1] * bfhi(g.x)); w.y = pk2(v0[2] * bflo(g.y), v0[3] * bfhi(g.y));
                w.z = pk2(v1[0] * bflo(g.z), v1[1] * bfhi(g.z)); w.w = pk2(v1[2] * bflo(g.w), v1[3] * bfhi(g.w));
                *(u32x4*)(Y + row * DM + col0) = w; }
    }
};
struct EpiGateP {
    static constexpr bool PERM = true, AFTER_DRAIN = false;
    bf16_t* LA; bf16_t* BB; const bf16_t* XC; const float* ba; const float* bx; const float* LC;
    __device__ __forceinline__ void operator()(const pg8::f32x4 (&acc)[2][2][4][2], const pg8::Unit& u, int wr, int wc, int fr, int fq) const {
        const int ch0 = 128 * u.pn + wc * 32 + 8 * fq;
        if (ch0 >= 320) return;
        const int row0 = u.pm * 256 + wr * 64 + fr; const int c = 320 * u.pz + ch0;
        float bav[8], bxv[8], lcv[8];
        { const float4 a0 = *(const float4*)(ba + c), a1 = *(const float4*)(ba + c + 4), x0 = *(const float4*)(bx + c), x1 = *(const float4*)(bx + c + 4), l0 = *(const float4*)(LC + c), l1 = *(const float4*)(LC + c + 4);
          bav[0] = a0.x; bav[1] = a0.y; bav[2] = a0.z; bav[3] = a0.w; bav[4] = a1.x; bav[5] = a1.y; bav[6] = a1.z; bav[7] = a1.w;
          bxv[0] = x0.x; bxv[1] = x0.y; bxv[2] = x0.z; bxv[3] = x0.w; bxv[4] = x1.x; bxv[5] = x1.y; bxv[6] = x1.z; bxv[7] = x1.w;
          lcv[0] = l0.x; lcv[1] = l0.y; lcv[2] = l0.z; lcv[3] = l0.w; lcv[4] = l1.x; lcv[5] = l1.y; lcv[6] = l1.z; lcv[7] = l1.w; }
#pragma unroll
        for (int ai = 0; ai < 2; ++ai)
#pragma unroll
            for (int m = 0; m < 4; ++m) { const size_t row = (size_t)(row0 + ai * 128 + m * 16);
                const u32x4 xv = *(const u32x4*)(XC + row * DRNN + c);
                const float xc[8] = {bflo(xv.x), bfhi(xv.x), bflo(xv.y), bfhi(xv.y), bflo(xv.z), bfhi(xv.z), bflo(xv.w), bfhi(xv.w)};
                float la[8], bt[8];
#pragma unroll
                for (int n = 0; n < 2; ++n)
#pragma unroll
                    for (int j = 0; j < 4; ++j) { const int e = 4 * n + j;
                        const float r = sigmoid_f(acc[ai][0][m][n][j] + bav[e]), ig = sigmoid_f(acc[ai][1][m][n][j] + bxv[e]);
                        la[e] = r * lcv[e]; const float av = __expf(la[e]); const float m2 = fmaxf(1.0f - av * av, 0.f); bt[e] = __builtin_amdgcn_sqrtf(m2) * ig * xc[e]; }
                u32x4 o1; o1.x = pk2(la[0], la[1]); o1.y = pk2(la[2], la[3]); o1.z = pk2(la[4], la[5]); o1.w = pk2(la[6], la[7]); *(u32x4*)(LA + row * NP2 + c) = o1;
                u32x4 o2; o2.x = pk2(bt[0], bt[1]); o2.y = pk2(bt[2], bt[3]); o2.z = pk2(bt[4], bt[5]); o2.w = pk2(bt[6], bt[7]); *(u32x4*)(BB + row * DRNN + c) = o2; }
    }
};


template <class ColMap>
HK_DI void transpose_convert(HK_LAS unsigned char* lds, const float* __restrict__ src, int ldsrc, int K, int n_tiles, ColMap cmap, bf16_t* __restrict__ dst, int vblk, int nblk, const float* __restrict__ kscale = nullptr) {
    constexpr int U = 4;
    HK_LAS float* sm = (HK_LAS float*)lds;
    const int tid = threadIdx.x;
    const int ktiles = K / 128, total = n_tiles * ktiles;
    for (int it0 = vblk; it0 < total; it0 += U * nblk) {
        int c0[U], k0[U], nt[U]; float4 va[U], vb[U];
#pragma unroll
        for (int u = 0; u < U; ++u) { const int it = it0 + u * nblk; const int kt = it / n_tiles; nt[u] = it - kt * n_tiles; k0[u] = kt * 128; c0[u] = (it < total) ? cmap(nt[u]) : -2;
            if (c0[u] >= 0) { const int kr = tid >> 2, q = tid & 3; const float4* p = (const float4*)(src + (size_t)(k0[u] + kr) * ldsrc + c0[u] + 8 * q); va[u] = p[0]; vb[u] = p[1]; } }
#pragma unroll
        for (int u = 0; u < U; ++u) if (c0[u] >= 0) { const int kr = tid >> 2, q = tid & 3; HK_LAS float* d = sm + u * (32 * 130) + (8 * q) * 130 + kr;
            const float sc = kscale ? kscale[k0[u] + kr] : 1.0f;
            d[0] = va[u].x * sc; d[130] = va[u].y * sc; d[260] = va[u].z * sc; d[390] = va[u].w * sc; d[520] = vb[u].x * sc; d[650] = vb[u].y * sc; d[780] = vb[u].z * sc; d[910] = vb[u].w * sc; }
        __syncthreads();
#pragma unroll
        for (int u = 0; u < U; ++u) if (c0[u] >= -1) {
            const int kp = tid & 63, w = tid >> 6;
#pragma unroll
            for (int i = 0; i < 4; ++i) {
                const int n = w + 8 * i;
                unsigned o = 0u;
                if (c0[u] >= 0) { const float lo = sm[u * (32 * 130) + n * 130 + 2 * kp], hi = sm[u * (32 * 130) + n * 130 + 2 * kp + 1]; o = pk2(lo, hi); }
                *(unsigned*)(dst + (size_t)(nt[u] * 32 + n) * K + k0[u] + 2 * kp) = o;
            }
        }
        __syncthreads();
    }
}

HK_DI void rmsnorm_rows_bf16(const float* __restrict__ x, const float* __restrict__ g, bf16_t* __restrict__ y, int nrows, int gwave, int nwaves, int lane) {
    for (int row = gwave; row < nrows; row += nwaves) {
        const float4* xr = (const float4*)(x + (size_t)row * DM);
        float4 v[16]; float ss = 0.f;
#pragma unroll
        for (int i = 0; i < 16; ++i) { v[i] = xr[lane + 64 * i]; ss += v[i].x * v[i].x + v[i].y * v[i].y + v[i].z * v[i].z + v[i].w * v[i].w; }
        ss = wave_sum(ss);
        const float inv = rsqrtf(ss * (1.0f / DM) + EPS);
#pragma unroll
        for (int i = 0; i < 16; ++i) { const float4 gg = ((const float4*)g)[lane + 64 * i];
            u32x2 o; o.x = pk2(v[i].x * inv * gg.x, v[i].y * inv * gg.y); o.y = pk2(v[i].z * inv * gg.z, v[i].w * inv * gg.w);
            *(u32x2*)(y + (size_t)row * DM + 4 * (lane + 64 * i)) = o; }
    }
}

HK_DI void rmsnorm_res_rows(const float* __restrict__ x, const bf16_t* __restrict__ r, const float* __restrict__ g, float* __restrict__ out1, bf16_t* __restrict__ y, int nrows, int gwave, int nwaves, int lane) {
    for (int row = gwave; row < nrows; row += nwaves) {
        const float4* xr = (const float4*)(x + (size_t)row * DM); const u32x2* rr = (const u32x2*)(r + (size_t)row * DM);
        float4 v[16]; float ss = 0.f;
#pragma unroll
        for (int i = 0; i < 16; ++i) { v[i] = xr[lane + 64 * i]; const u32x2 w = rr[lane + 64 * i];
            v[i].x += bflo(w.x); v[i].y += bfhi(w.x); v[i].z += bflo(w.y); v[i].w += bfhi(w.y);
            ss += v[i].x * v[i].x + v[i].y * v[i].y + v[i].z * v[i].z + v[i].w * v[i].w; }
        ss = wave_sum(ss);
        const float inv = rsqrtf(ss * (1.0f / DM) + EPS);
#pragma unroll
        for (int i = 0; i < 16; ++i) { const float4 gg = ((const float4*)g)[lane + 64 * i];
            { u32x2 xw; xw.x = pk2(v[i].x, v[i].y); xw.y = pk2(v[i].z, v[i].w);
              ((u32x2*)(out1 + (size_t)row * DM + DM / 2))[lane + 64 * i] = xw; }
            u32x2 o; o.x = pk2(v[i].x * inv * gg.x, v[i].y * inv * gg.y); o.y = pk2(v[i].z * inv * gg.z, v[i].w * inv * gg.w);
            *(u32x2*)(y + (size_t)row * DM + 4 * (lane + 64 * i)) = o; }
    }
}

struct WinMap { HK_DI int operator()(int nt) const { const int n = nt * 32; return n < 4608 ? n : (n < 14848 ? n + 96 : (n < 14944 ? n - 14848 + 4608 : -1)); } };
struct IdMap { HK_DI int operator()(int nt) const { return nt * 32; } };
struct PadMap128 { HK_DI int operator()(int nt) const { return nt < 4 ? nt * 32 : -1; } };

HK_DI void phase0_prologue(HK_LAS unsigned char* lds, const Args& a) {
    const int tid = threadIdx.x, lane = tid & 63, wave = tid >> 6, blk = blockIdx.x, nblk = gridDim.x;
    unsigned char* ws = a.ws;
    transpose_convert(lds, a.in[4], 14944, 4096, NP / 32, WinMap(), (bf16_t*)(ws + WS_WIN_T), blk, nblk);
    transpose_convert(lds, a.in[10], 4096, 4096, 4096 / 32, IdMap(), (bf16_t*)(ws + WS_WOUT_T), blk, nblk);
    transpose_convert(lds, a.in[11], 10240, 4096, 10240 / 32, IdMap(), (bf16_t*)(ws + WS_RWIN_T), blk, nblk, a.in[1] + DM);
    transpose_convert(lds, a.in[19], 4096, 5120, 4096 / 32, IdMap(), (bf16_t*)(ws + WS_RWOUT_T), blk, nblk);
    for (int h = 0; h < 16; ++h)
        transpose_convert(lds, a.in[7] + (size_t)h * 512 * 128, 128, 512, 256 / 32, PadMap128(), (bf16_t*)(ws + WS_WUVT) + (size_t)h * 256 * 512, blk, nblk);
    const size_t gtid = (size_t)blk * NTHREADS + tid, gstride = (size_t)nblk * NTHREADS;
    { const float4* s = (const float4*)a.in[6]; u32x2* d = (u32x2*)(ws + WS_WUK);
      for (size_t i = gtid; i < 16ull * 512 * 256 / 4; i += gstride) { const size_t rowi = i >> 6; const int k4 = (int)(i & 63);
          u32x2 o; o.x = 0u; o.y = 0u; if (k4 < 32) { const float4 v = s[rowi * 32 + k4]; o.x = pk2(v.x, v.y); o.y = pk2(v.z, v.w); } d[i] = o; } }
    { bf16_t* d = (bf16_t*)(ws + WS_WG_T); const float* wa = a.in[14]; const float* wx = a.in[16];
      for (size_t i = gtid; i < 16ull * 768 * 384; i += gstride) { const int k = (int)(i % 384); const size_t r = i / 384; const int jp = (int)(r % 768), z = (int)(r / 768);
          const int within = jp & 255; const float* w = (within < 128) ? wa : wx; const int col = 128 * (jp >> 8) + (within & 127);
          d[i] = (col < 320 && k < 320) ? f2bf(w[((size_t)z * 320 + k) * 320 + col]) : (bf16_t)0; } }
    { float* bt = (float*)(ws + WS_BT); const float* rb = a.in[3];
      for (size_t i = gtid; i < 32 * 129; i += gstride) { const int h = (int)(i / 129), d = (int)(i % 129); bt[h * BT_PITCH + d] = rb[t5_bucket(d) * 32 + h]; } }
    { float* lc = (float*)(ws + WS_LC); const float* lam = a.in[18];
      for (size_t i = gtid; i < DRNN; i += gstride) lc[i] = -8.0f * log1pf(expf(-lam[i])); }
    rmsnorm_rows_bf16(a.in[0], a.in[1], (bf16_t*)(ws + WS_H), NTOK, blk * 8 + wave, nblk * 8, lane);
}

HK_DI void phase2_post(HK_LAS unsigned char* lds, const Args& a) {
    const int tid = threadIdx.x, lane = tid & 63, wave = tid >> 6, blk = blockIdx.x, nblk = gridDim.x;
    unsigned char* ws = a.ws;
    const bf16_t* PROJ = (const bf16_t*)(ws + WS_PROJ);
    { bf16_t* CKVN = (bf16_t*)(ws + WS_CKVN); bf16_t* KIN = (bf16_t*)(ws + WS_KIN); float* WI = (float*)(ws + WS_WI);
      const float* kvg = a.in[5]; const float* kg = a.in[8]; const float* kb = a.in[9];
      for (int tok = blk * 8 + wave; tok < NTOK; tok += nblk * 8) {
          const bf16_t* pr = PROJ + (size_t)tok * NP;
          const u32x4 c = *(const u32x4*)(pr + CKV_OFF + 8 * lane);
          float v[8] = {bflo(c.x), bfhi(c.x), bflo(c.y), bfhi(c.y), bflo(c.z), bfhi(c.z), bflo(c.w), bfhi(c.w)};
          float ss = 0.f;
#pragma unroll
          for (int j = 0; j < 8; ++j) ss += v[j] * v[j];
          ss = wave_sum(ss);
          const float inv = rsqrtf(ss * (1.0f / 512.0f) + EPS);
          const float4 g0 = ((const float4*)kvg)[2 * lane], g1 = ((const float4*)kvg)[2 * lane + 1];
          u32x4 o; o.x = pk2(v[0] * inv * g0.x, v[1] * inv * g0.y); o.y = pk2(v[2] * inv * g0.z, v[3] * inv * g0.w);
          o.z = pk2(v[4] * inv * g1.x, v[5] * inv * g1.y); o.w = pk2(v[6] * inv * g1.z, v[7] * inv * g1.w);
          *(u32x4*)(CKVN + (size_t)tok * 512 + 8 * lane) = o;
          const float kv = bf2f(pr[KI_OFF + lane]);
          const float mu = wave_sum(kv) * (1.0f / 64.0f);
          const float dv = kv - mu;
          const float var = wave_sum(dv * dv) * (1.0f / 64.0f);
          KIN[(size_t)tok * 64 + lane] = f2bf(dv * rsqrtf(var + EPS) * kg[lane] + kb[lane]);
          if (lane < 32) WI[(size_t)tok * 32 + lane] = bf2f(pr[WI_OFF + lane]);
      } }
    { float* KM = (float*)(ws + WS_KMEAN); HK_LAS float* red = (HK_LAS float*)lds;
      const int cg = tid & 15, rg = tid >> 4;
      for (int it = blk; it < 1024; it += nblk) {
          const int h = it & 15, bk = it >> 4;
          const bf16_t* base = PROJ + (size_t)(bk * 256 + rg) * NP + KB_OFF + h * 128 + 8 * cg;
          float sacc[8] = {0.f, 0.f, 0.f, 0.f, 0.f, 0.f, 0.f, 0.f};
#pragma unroll
          for (int r = 0; r < 8; ++r) { const u32x4 w = *(const u32x4*)(base + (size_t)(32 * r) * NP);
              sacc[0] += bflo(w.x); sacc[1] += bfhi(w.x); sacc[2] += bflo(w.y); sacc[3] += bfhi(w.y); sacc[4] += bflo(w.z); sacc[5] += bfhi(w.z); sacc[6] += bflo(w.w); sacc[7] += bfhi(w.w); }
          __syncthreads();
          *(HK_LAS f32x4*)(red + rg * 128 + 8 * cg) = (f32x4){sacc[0], sacc[1], sacc[2], sacc[3]};
          *(HK_LAS f32x4*)(red + rg * 128 + 8 * cg + 4) = (f32x4){sacc[4], sacc[5], sacc[6], sacc[7]};
          __syncthreads();
          if (tid < 128) { float t = 0.f;
#pragma unroll
              for (int g2 = 0; g2 < 32; ++g2) t += red[g2 * 128 + tid];
              KM[(size_t)it * 128 + tid] = t * (1.0f / 256.0f); }
      }
      __syncthreads(); }
    { bf16_t* VT = (bf16_t*)(ws + WS_VT); HK_LAS bf16_t* sm = (HK_LAS bf16_t*)lds;
      for (int it = blk; it < 4 * 16 * 64; it += nblk) {
          const int tt = it & 63, bh = it >> 6, h = bh & 15, b = bh >> 4;
          __syncthreads();
#pragma unroll
          for (int i = 0; i < 2; ++i) { const int c = tid + 512 * i, r = c >> 4, dc = c & 15;
              const u32x4 w = *(const u32x4*)(PROJ + (size_t)(b * 4096 + tt * 64 + r) * NP + VB_OFF + h * 128 + 8 * dc);
              const int rp = (r & 32) | ((r & 12) << 1) | ((r & 16) >> 2) | (r & 3);
              HK_LAS bf16_t* p = sm + (8 * dc) * 72 + rp;
              p[0] = (bf16_t)(w.x & 0xffff); p[72] = (bf16_t)(w.x >> 16); p[144] = (bf16_t)(w.y & 0xffff); p[216] = (bf16_t)(w.y >> 16);
              p[288] = (bf16_t)(w.z & 0xffff); p[360] = (bf16_t)(w.z >> 16); p[432] = (bf16_t)(w.w & 0xffff); p[504] = (bf16_t)(w.w >> 16); }
          __syncthreads();
#pragma unroll
          for (int i = 0; i < 2; ++i) { const int c = tid + 512 * i, d = c >> 3, tc = c & 7;
              const u32x4 w = *(const HK_LAS u32x4*)(sm + d * 72 + 8 * tc);
              *(u32x4*)(VT + ((size_t)bh * 128 + d) * 4096 + tt * 64 + 8 * tc) = w; }
      }
      __syncthreads(); }
}

HK_DI unsigned f2ord(float x) { const unsigned u = __float_as_uint(x); return (u & 0x80000000u) ? ~u : (u | 0x80000000u); }

HK_DI void phase3_indexer(HK_LAS unsigned char* lds, const Args& a) {
    const int tid = threadIdx.x, lane = tid & 63, wave = __builtin_amdgcn_readfirstlane(tid >> 6);
    unsigned char* ws = a.ws;
    const bf16_t* PROJ = (const bf16_t*)(ws + WS_PROJ); const bf16_t* KIN = (const bf16_t*)(ws + WS_KIN); const float* WI = (const float*)(ws + WS_WI);
    bf16_t* IDX = (bf16_t*)(ws + WS_IDX);
    const int W = blockIdx.x * 8 + wave, NW = gridDim.x * 8;
    const int l31 = lane & 31, hf2 = lane >> 5;
    const unsigned rdb = (unsigned)(uintptr_t)lds + l31 * 128 + 16 * (hf2 ^ ((l31 >> 1) & 7));
    const int drow = tid >> 3, dpos = tid & 7;
    const int dsrc = drow * 64 + 8 * (dpos ^ ((drow >> 1) & 7));
    const int wave1024 = (wave & 7) * 1024;
    for (int q0 = W, qi = 0; q0 < NTOK; q0 += NW, ++qi) {
        int q = q0; int tmaxb;
        if (NW == 2048) { const int bb = qi >> 1; q = bb * 4096 + ((qi & 1) ? 4095 - W : W); tmaxb = (qi & 1) ? 4095 - 8 * (int)blockIdx.x : 8 * (int)blockIdx.x + 7; }
        else { const int qlast = q0 - wave + 7; tmaxb = ((q0 - wave) >> 12) == (qlast >> 12) ? (qlast & 4095) : 4095; }
        const int b = q >> 12, t = q & 4095;
        bf16_t* idx_out = IDX + (size_t)q * 256;
        if (tmaxb < 256) {
#pragma unroll
            for (int k = 0; k < 4; ++k) { const int s = lane + 64 * k; idx_out[s] = (bf16_t)(s <= t ? s : 0); }
            continue;
        }
        const bf16_t* qrow = PROJ + (size_t)q * NP + QI_OFF + l31 * 64 + 8 * hf2;
        bf16x8 A[4];
#pragma unroll
        for (int ks = 0; ks < 4; ++ks) A[ks] = *(const bf16x8*)(qrow + 16 * ks);
        float wv[16];
#pragma unroll
        for (int r = 0; r < 16; ++r) wv[r] = WI[(size_t)q * 32 + (r & 3) + 8 * (r >> 2) + 4 * hf2];
        const bf16_t* kb = KIN + (size_t)(b * 4096) * 64 + dsrc;
        const int ngb = (tmaxb >> 6) + 1;
        const int ng = ngb;
        unsigned key[64];
        asm volatile("s_waitcnt vmcnt(0)" ::: "memory");
        __syncthreads();
#define HK_IDX_ISSUE(j) __builtin_amdgcn_global_load_lds((const unsigned*)(kb + (size_t)(j) * 4096), (HK_LAS unsigned*)(lds + ((j) & 7) * 8192 + wave1024), 16, 0, 0)
#define HK_IDX_ISSUE_TO(g, slot) __builtin_amdgcn_global_load_lds((const unsigned*)(kb + (size_t)(g) * 4096), (HK_LAS unsigned*)(lds + (slot) * 8192 + wave1024), 16, 0, 0)
#define HK_IDX_RELU(x) __int_as_float(max(__float_as_int(x), 0))
#define HK_IDX_TILE(j, hf, pout) do { f32x16 a0; \
            _Pragma("unroll") for (int r = 0; r < 16; ++r) a0[r] = 0.f; \
            _Pragma("unroll") for (int ks = 0; ks < 4; ++ks) a0 = __builtin_amdgcn_mfma_f32_32x32x16_bf16(A[ks], *(const HK_LAS bf16x8*)(uintptr_t)((rdb ^ (unsigned)(32 * ks)) + ((j) & 7) * 8192 + 4096 * (hf)), a0, 0, 0, 0); \
            float u0 = 0.f, u1 = 0.f; \
            _Pragma("unroll") for (int r = 0; r < 16; r += 2) { u0 += wv[r] * HK_IDX_RELU(a0[r]); u1 += wv[r + 1] * HK_IDX_RELU(a0[r + 1]); } \
            pout = u0 + u1; } while (0)
        HK_IDX_ISSUE(0); HK_IDX_ISSUE(1); HK_IDX_ISSUE(2); HK_IDX_ISSUE(3); HK_IDX_ISSUE(4); HK_IDX_ISSUE(5); HK_IDX_ISSUE(6);
#pragma unroll
        for (int j = 0; j < 64; ++j) {
            if (j < ngb) {
                asm volatile("s_waitcnt vmcnt(6)" ::: "memory");
                __builtin_amdgcn_s_barrier();
                asm volatile("" ::: "memory");
                HK_IDX_ISSUE_TO((j + 7) & 63, (j + 7) & 7);
                float p0, p1;
                HK_IDX_TILE(j, 0, p0);
                HK_IDX_TILE(j, 1, p1);
                const auto sw_ = __builtin_amdgcn_permlane32_swap(__float_as_uint(p0), __float_as_uint(p1), false, false);
                const float v_ = __uint_as_float(sw_[0]) + __uint_as_float(sw_[1]);
                key[j] = (64 * j + lane <= t) ? f2ord(v_) : 0u;
            } else key[j] = 0u;
        }
#undef HK_IDX_ISSUE
#undef HK_IDX_ISSUE_TO
#undef HK_IDX_RELU
#undef HK_IDX_TILE
        typedef unsigned short u16x2 __attribute__((ext_vector_type(2)));
        unsigned T;
        {
            u16x2 hp[32];
#pragma unroll
            for (int k = 0; k < 32; ++k) hp[k] = __builtin_bit_cast(u16x2, (key[2 * k] >> 16) | (key[2 * k + 1] & 0xffff0000u));
#define HK_IDX_COUNT(arr, cm1, out) do { const unsigned cmu_ = ((unsigned)(cm1) & 0xffffu) * 0x00010001u; unsigned accu_ = 0u; \
            int ngx_ = ng; asm volatile("" : "+s"(ngx_)); \
            _Pragma("unroll") for (int g8 = 0; g8 < 8; ++g8) if (8 * g8 < ngx_) { \
                _Pragma("unroll") for (int jj = 0; jj < 4; ++jj) { unsigned t_;        \
                    asm("v_pk_sub_u16 %0, %2, %3 clamp\n\tv_pk_min_u16 %0, %0, %4\n\tv_pk_add_u16 %1, %1, %0" : "=&v"(t_), "+v"(accu_) : "v"(__builtin_bit_cast(unsigned, arr[4 * g8 + jj])), "v"(cmu_), "v"(0x00010001u)); } } \
            unsigned v_ = accu_; v_ = (v_ & 0xffffu) + (v_ >> 16); \
            { const auto r_ = __builtin_amdgcn_permlane32_swap(v_, v_, false, false); v_ = r_[0] + r_[1]; } \
            { const auto r_ = __builtin_amdgcn_permlane16_swap(v_, v_, false, false); v_ = r_[0] + r_[1]; } \
            v_ += (unsigned)__builtin_amdgcn_mov_dpp((int)v_, 0x128, 0xf, 0xf, false); v_ += (unsigned)__builtin_amdgcn_mov_dpp((int)v_, 0x124, 0xf, 0xf, false); \
            v_ += (unsigned)__builtin_amdgcn_mov_dpp((int)v_, 0x122, 0xf, 0xf, false); v_ += (unsigned)__builtin_amdgcn_mov_dpp((int)v_, 0x121, 0xf, 0xf, false); \
            out = __builtin_amdgcn_readfirstlane((int)v_); } while (0)
            unsigned Th = 0u; bool exact = false;
            for (int bit = 15; bit >= 0; --bit) {
                const unsigned cand = Th | (1u << bit); int cnt;
                HK_IDX_COUNT(hp, cand - 1u, cnt);
                if (cnt >= 256) { Th = cand; if (cnt == 256) { exact = true; break; } }
            }
            unsigned Tl = 0u;
            if (!exact) {
                int G = 0;
                if (Th != 0xffffu) HK_IDX_COUNT(hp, Th, G);
                const int need = 256 - G;
#pragma unroll
                for (int k = 0; k < 32; ++k) { const unsigned k0 = key[2 * k], k1 = key[2 * k + 1];
                    const unsigned l0 = ((k0 >> 16) == Th) ? (k0 & 0xffffu) : 0u, l1 = ((k1 >> 16) == Th) ? (k1 << 16) : 0u;
                    hp[k] = __builtin_bit_cast(u16x2, l0 | l1); }
                for (int bit = 15; bit >= 0; --bit) {
                    const unsigned cand = Tl | (1u << bit); int cnt;
                    HK_IDX_COUNT(hp, cand - 1u, cnt);
                    if (cnt >= need) { Tl = cand; if (cnt == need) break; }
                }
            }
#undef HK_IDX_COUNT
            T = (Th << 16) | Tl;
        }
        int base = 0; int ng1 = ng, ng2 = ng; asm volatile("" : "+s"(ng1)); asm volatile("" : "+s"(ng2));
#pragma unroll
        for (int g8 = 0; g8 < 8; ++g8) if (8 * g8 < ng1)
#pragma unroll
        for (int jj = 0; jj < 8; ++jj) { const int j = 8 * g8 + jj;
            const bool sel = key[j] > T; const unsigned long long m = __ballot(sel);
            const int pos = base + __builtin_amdgcn_mbcnt_hi((unsigned)(m >> 32), __builtin_amdgcn_mbcnt_lo((unsigned)m, 0u));
            if (sel) idx_out[pos] = (bf16_t)(64 * j + lane);
            base += __popcll(m);
        }
#pragma unroll
        for (int g8 = 0; g8 < 8; ++g8) if (8 * g8 < ng2)
#pragma unroll
        for (int jj = 0; jj < 8; ++jj) { const int j = 8 * g8 + jj;
            const bool sel = key[j] == T; const unsigned long long m = __ballot(sel);
            if (m != 0ull) {
                const int pos = base + __builtin_amdgcn_mbcnt_hi((unsigned)(m >> 32), __builtin_amdgcn_mbcnt_lo((unsigned)m, 0u));
                if (sel && pos < 256) idx_out[pos] = (bf16_t)(64 * j + lane);
                base += __popcll(m); }
        }
    }
}

template <int OFF>
HK_DI void tr4(u32x2 (&r)[4], unsigned a0, unsigned a1, unsigned a2, unsigned a3) {
    asm volatile("ds_read_b64_tr_b16 %0, %4 offset:%8\n\tds_read_b64_tr_b16 %1, %5 offset:%8\n\tds_read_b64_tr_b16 %2, %6 offset:%8\n\tds_read_b64_tr_b16 %3, %7 offset:%8\n\ts_waitcnt lgkmcnt(0)"
                 : "=&v"(r[0]), "=&v"(r[1]), "=&v"(r[2]), "=&v"(r[3]) : "v"(a0), "v"(a1), "v"(a2), "v"(a3), "n"(OFF) : "memory");
}
#define HK_TR4_ASM(OFFS) "ds_read_b64_tr_b16 %0, %4 offset:" OFFS "\n\tds_read_b64_tr_b16 %1, %5 offset:" OFFS "\n\tds_read_b64_tr_b16 %2, %6 offset:" OFFS "\n\tds_read_b64_tr_b16 %3, %7 offset:" OFFS
template <int OFF>
HK_DI void dsa_rd4(u32x2 (&r)[4], unsigned a0, unsigned a1, unsigned a2, unsigned a3) {
    asm volatile("ds_read_b64_tr_b16 %0, %4 offset:%8\n\tds_read_b64_tr_b16 %1, %5 offset:%8\n\tds_read_b64_tr_b16 %2, %6 offset:%8\n\tds_read_b64_tr_b16 %3, %7 offset:%8"
                 : "=&v"(r[0]), "=&v"(r[1]), "=&v"(r[2]), "=&v"(r[3]) : "v"(a0), "v"(a1), "v"(a2), "v"(a3), "n"(OFF) : "memory");
}
template <int N> HK_DI void dsa_wait4(u32x2 (&r)[4]) { asm volatile("s_waitcnt lgkmcnt(%4)" : "+v"(r[0]), "+v"(r[1]), "+v"(r[2]), "+v"(r[3]) : "n"(N) : "memory"); }
template <int OFF>
HK_DI void dsa_pv16(f32x4 (&O)[16], unsigned a0in, const bf16x4 Pf) {
    u32x2 ra[4], rb[4];
    unsigned a0 = a0in; asm volatile("" : "+v"(a0));
    const unsigned a1 = a0 ^ 32u, a2 = a0 ^ 64u, a3 = a0 ^ 96u, a4 = a0 ^ 128u, a5 = a0 ^ 160u, a6 = a0 ^ 192u, a7 = a0 ^ 224u;
    dsa_rd4<OFF>(ra, a0, a1, a2, a3);
    dsa_rd4<OFF>(rb, a4, a5, a6, a7);
    dsa_wait4<4>(ra);
#pragma unroll
    for (int i = 0; i < 4; ++i) O[i] = __builtin_amdgcn_mfma_f32_16x16x16bf16_1k(__builtin_bit_cast(bf16x4, ra[i]), Pf, O[i], 0, 0, 0);
    __builtin_amdgcn_sched_barrier(0);
    dsa_rd4<OFF + 256>(ra, a0, a1, a2, a3);
    dsa_wait4<4>(rb);
#pragma unroll
    for (int i = 0; i < 4; ++i) O[4 + i] = __builtin_amdgcn_mfma_f32_16x16x16bf16_1k(__builtin_bit_cast(bf16x4, rb[i]), Pf, O[4 + i], 0, 0, 0);
    __builtin_amdgcn_sched_barrier(0);
    dsa_rd4<OFF + 256>(rb, a4, a5, a6, a7);
    dsa_wait4<4>(ra);
#pragma unroll
    for (int i = 0; i < 4; ++i) O[8 + i] = __builtin_amdgcn_mfma_f32_16x16x16bf16_1k(__builtin_bit_cast(bf16x4, ra[i]), Pf, O[8 + i], 0, 0, 0);
    dsa_wait4<0>(rb);
#pragma unroll
    for (int i = 0; i < 4; ++i) O[12 + i] = __builtin_amdgcn_mfma_f32_16x16x16bf16_1k(__builtin_bit_cast(bf16x4, rb[i]), Pf, O[12 + i], 0, 0, 0);
}
struct DsaSt { f32x4 O[16]; bf16x8 Bq[8]; float mrun, lsum; unsigned ad0, rbase; int t, nsel, fr, fq, lane; unsigned seq; volatile HK_LAS unsigned* flag_me; volatile HK_LAS unsigned* flag_pa; };
template <int BI>
HK_DI void dsa4_chunk(HK_LAS unsigned char* buf, HK_LAS unsigned char* xs_me, const HK_LAS unsigned char* xs_pa, const HK_LAS bf16_t* widx, const HK_LAS float* btl, DsaSt& st, const int kt, const float c2) {
    const u32x2 iw = *(const HK_LAS u32x2*)(widx + 16 * kt + 4 * st.fq);
    const int s4[4] = {(int)(iw.x & 0xffff), (int)(iw.x >> 16), (int)(iw.y & 0xffff), (int)(iw.y >> 16)};
    float bias4[4];
#pragma unroll
    for (int j = 0; j < 4; ++j) { int d = st.t - s4[j]; d = d < 0 ? 0 : (d > 128 ? 128 : d); bias4[j] = btl[st.fr * 129 + d]; }
    f32x4 acc = (f32x4){0.f, 0.f, 0.f, 0.f};
#pragma unroll
    for (int k4 = 0; k4 < 2; ++k4) {
        bf16x8 Af[4];
#pragma unroll
        for (int k3 = 0; k3 < 4; ++k3) Af[k3] = *(const HK_LAS bf16x8*)(uintptr_t)((st.rbase ^ (unsigned)(64 * k3)) + 8192 * BI + 256 * k4);
#pragma unroll
        for (int k3 = 0; k3 < 4; ++k3) acc = __builtin_amdgcn_mfma_f32_16x16x32_bf16(Af[k3], st.Bq[4 * k4 + k3], acc, 0, 0, 0);
    }
    *(HK_LAS f32x4*)(xs_me + 1024 * BI + 16 * st.lane) = acc;
    asm volatile("s_waitcnt lgkmcnt(0)" ::: "memory");
    *st.flag_me = st.seq;
    {
        unsigned spins = 0u;
        while ((unsigned)__builtin_amdgcn_readfirstlane(*st.flag_pa) < st.seq) { __builtin_amdgcn_s_sleep(1); if (++spins > (1u << 22)) break; }
    }
    asm volatile("" ::: "memory");
    acc += *(const HK_LAS f32x4*)(xs_pa + 1024 * BI + 16 * st.lane);
    st.seq += 1u;
    float v[4]; float tmax = -INFINITY;
#pragma unroll
    for (int j = 0; j < 4; ++j) { const int k = 16 * kt + 4 * st.fq + j;
        v[j] = (k < st.nsel) ? acc[j] * c2 + bias4[j] : -INFINITY; tmax = fmaxf(tmax, v[j]); }
    tmax = rows_max(tmax);
    const float mnew = fmaxf(st.mrun, tmax);
    const float msafe = (mnew == -INFINITY) ? 0.f : mnew;
    if (__ballot(mnew != st.mrun) != 0ull) {
        const float alpha = __builtin_amdgcn_exp2f(st.mrun - msafe);
        st.lsum *= alpha;
#pragma unroll
        for (int i = 0; i < 16; ++i) st.O[i] *= alpha;
    }
    st.mrun = mnew;
    float p[4];
#pragma unroll
    for (int j = 0; j < 4; ++j) { p[j] = __builtin_amdgcn_exp2f(v[j] - msafe); st.lsum += p[j]; }
    u32x2 pw; pw.x = pk2(p[0], p[1]); pw.y = pk2(p[2], p[3]);
    const bf16x4 Pf = __builtin_bit_cast(bf16x4, pw);
    dsa_pv16<8192 * BI>(st.O, st.ad0, Pf);
}
HK_DI void phase4_dsa(HK_LAS unsigned char* lds, const Args& a) {
    const int tid = threadIdx.x, lane = tid & 63, wave = __builtin_amdgcn_readfirstlane(tid >> 6), fr = lane & 15, fq = lane >> 4;
    const int pair = wave >> 1, hf = wave & 1;
    unsigned char* ws = a.ws;
    const bf16_t* CKVN = (const bf16_t*)(ws + WS_CKVN); const bf16_t* IDX = (const bf16_t*)(ws + WS_IDX); const float* BT = (const float*)(ws + WS_BT);
    bf16_t* QL = (bf16_t*)a.out;
    HK_LAS unsigned char* buf = lds + (wave & 7) * 16384;
    HK_LAS bf16_t* widx = (HK_LAS bf16_t*)(lds + 131072 + (wave & 7) * 512);
    HK_LAS unsigned char* xs_me = lds + 131072 + 4096 + (wave & 7) * 2048;
    const HK_LAS unsigned char* xs_pa = lds + 131072 + 4096 + ((wave ^ 1) & 7) * 2048;
    HK_LAS float* btl = (HK_LAS float*)(lds + 131072 + 4096 + 16384);
    for (int i = tid; i < 16 * 129; i += NTHREADS) btl[i] = BT[(i / 129) * BT_PITCH + (i % 129)] * 1.4426950408889634f;
    DsaSt st; st.fr = fr; st.fq = fq; st.lane = lane; st.seq = 1u;
    st.flag_me = (volatile HK_LAS unsigned*)(lds + 131072 + 4096 + 16384 + 8448 + (wave & 7) * 64);
    st.flag_pa = (volatile HK_LAS unsigned*)(lds + 131072 + 4096 + 16384 + 8448 + ((wave ^ 1) & 7) * 64);
    if (lane == 0) *st.flag_me = 0u;
    __syncthreads();
    { const int q4 = fr >> 2, pp = fr & 3, row = 4 * fq + q4, f = ((2 * row) | (row >> 3)) & 15;
      st.ad0 = (unsigned)(uintptr_t)buf + row * 512 + 16 * ((pp >> 1) ^ f) + 8 * (pp & 1); }
    { const int f = ((2 * fr) | (fr >> 3)) & 15; st.rbase = (unsigned)(uintptr_t)buf + fr * 512 + 16 * (fq ^ f); }
    const float c2 = ATTN_SCALE * 1.4426950408889634f;
    const int hi5 = lane >> 5, p31 = lane & 31;
    const unsigned xsw = 16u * (unsigned)(p31 ^ (2 * hi5));
    const bool xmap = (gridDim.x == 256);
    const int PW = blockIdx.x * 4 + pair, NPW = gridDim.x * 4;
    const int xb = (blockIdx.x & 7) >> 1, lp = (((blockIdx.x & 1) * 32 + (blockIdx.x >> 3)) * 4 + pair);
    const int nq = xmap ? 16 : (NTOK + NPW - 1) / NPW;
    u32x2 iw_cur; bf16x8 BqN[8];
#define HK_DSA_Q(qi_) (xmap ? (xb * 4096 + lp + 256 * (qi_)) : (((PW + NPW * (qi_)) < NTOK) ? (PW + NPW * (qi_)) : NTOK - 1))
    { const int q0_ = HK_DSA_Q(0); iw_cur = *(const u32x2*)(IDX + (size_t)q0_ * 256 + 4 * lane);
      const bf16_t* qp = QL + (size_t)q0_ * 8192 + fr * 512 + 256 * hf + 8 * fq;
#pragma unroll
      for (int ks = 0; ks < 8; ++ks) BqN[ks] = *(const bf16x8*)(qp + 32 * ks); }
    for (int qi = 0; qi < nq; ++qi) {
        const int q = HK_DSA_Q(qi);
        const int b = q >> 12, t = q & 4095;
        st.t = t; st.nsel = t < 255 ? t + 1 : 256;
        asm volatile("s_waitcnt vmcnt(0)" ::: "memory");
        *(HK_LAS u32x2*)(widx + 4 * lane) = iw_cur;
#pragma unroll
        for (int ks = 0; ks < 8; ++ks) st.Bq[ks] = BqN[ks];
        if (qi + 1 < nq) { const int qn = HK_DSA_Q(qi + 1); iw_cur = *(const u32x2*)(IDX + (size_t)qn * 256 + 4 * lane);
            const bf16_t* qp = QL + (size_t)qn * 8192 + fr * 512 + 256 * hf + 8 * fq;
#pragma unroll
            for (int ks = 0; ks < 8; ++ks) BqN[ks] = *(const bf16x8*)(qp + 32 * ks); }
#pragma unroll
        for (int i = 0; i < 16; ++i) st.O[i] = (f32x4){0.f, 0.f, 0.f, 0.f};
        st.mrun = -INFINITY; st.lsum = 0.f;
        const bf16_t* cbase = CKVN + (size_t)(b * 4096) * 512 + 256 * hf;
        asm volatile("s_waitcnt lgkmcnt(0)" ::: "memory");
#define HK_DSA_ISSUE(kt, bi) do { \
            const HK_LAS unsigned short* wl_ = (const HK_LAS unsigned short*)widx + 16 * (kt) + hi5;        \
            unsigned rows_[8]; \
            _Pragma("unroll") for (int i_ = 0; i_ < 8; ++i_) rows_[i_] = wl_[2 * i_]; \
            _Pragma("unroll") for (int i_ = 0; i_ < 8; ++i_) { const unsigned ci_ = ((4u * i_) & 15u) | (i_ >= 4 ? 1u : 0u);        \
                const unsigned off_ = (rows_[i_] << 10) | (xsw ^ (16u * ci_));        \
                __builtin_amdgcn_global_load_lds((const unsigned*)((const char*)cbase + off_), (HK_LAS unsigned*)(buf + 8192 * (bi) + 1024 * i_), 16, 0, 0); } } while (0)
        HK_DSA_ISSUE(0, 0);
#pragma unroll 1
        for (int k2 = 0; k2 < 8; ++k2) {
            HK_DSA_ISSUE(2 * k2 + 1, 1);
            asm volatile("s_waitcnt vmcnt(8)" ::: "memory");
            dsa4_chunk<0>(buf, xs_me, xs_pa, widx, btl, st, 2 * k2, c2);
            if (k2 < 7) { HK_DSA_ISSUE(2 * k2 + 2, 0); asm volatile("s_waitcnt vmcnt(8)" ::: "memory"); }
            else asm volatile("s_waitcnt vmcnt(0)" ::: "memory");
            dsa4_chunk<1>(buf, xs_me, xs_pa, widx, btl, st, 2 * k2 + 1, c2);
        }
#undef HK_DSA_ISSUE
        const float lsum = rows_sum(st.lsum);
        const float inv = 1.0f / lsum;
        bf16_t* op = ((a.pad & 4) ? ((bf16_t*)(ws + WS_VT) + (size_t)PW * 8192) : (QL + (size_t)q * 8192)) + fr * 512 + 256 * hf + 16 * (fq & 1) + 8 * (fq >> 1);
#pragma unroll
        for (int mp = 0; mp < 8; ++mp) { const int ma = 2 * mp, mb = 2 * mp + 1;
            unsigned ax = pk2(st.O[ma][0] * inv, st.O[ma][1] * inv), ay = pk2(st.O[ma][2] * inv, st.O[ma][3] * inv);
            unsigned bx = pk2(st.O[mb][0] * inv, st.O[mb][1] * inv), by = pk2(st.O[mb][2] * inv, st.O[mb][3] * inv);
            const auto sx = __builtin_amdgcn_permlane16_swap(ax, bx, false, false); const auto sy = __builtin_amdgcn_permlane16_swap(ay, by, false, false);
            u32x4 w; w.x = sx[0]; w.y = sy[0]; w.z = sx[1]; w.w = sy[1];
            *(u32x4*)(op + 32 * mp) = w; }
        asm volatile("s_waitcnt vmcnt(0) lgkmcnt(0)" ::: "memory");
    }
}

struct MobaSt {
    f32x4 o[2][8]; float mrun[2], lrun[2]; bf16x8 Qf[2][4]; unsigned mymask[2]; int tq[2];
    const bf16_t* ksrc[2]; const bf16_t* vsrc[2];
    int own, ntile, wave1024, fr, fq, wave32, tq0; float b128;
};
template <int S, bool FAR>
HK_DI void moba_scores(const HK_LAS unsigned char* kst, const HK_LAS float* btl, const MobaSt& st, const int s0, const int n, const bool past, const float c2,
                       float (&tmax)[2], float (&ps)[2], float (&tsh)[2], bf16x8 (&Pf)[2][2]) {
    const int fr = st.fr, fq = st.fq;
    f32x4 sa[2][2][2];
#pragma unroll
    for (int kk = 0; kk < 2; ++kk)
#pragma unroll
        for (int m2 = 0; m2 < 2; ++m2) {
            const int mt = 2 * kk + m2;
            bf16x8 Af[4];
#pragma unroll
            for (int ks = 0; ks < 4; ++ks) Af[ks] = *(const HK_LAS bf16x8*)(kst + (16 * mt + fr) * 256 + 16 * ((4 * ks + fq) ^ fr));
#pragma unroll
            for (int g = 0; g < 2; ++g) {
                f32x4 acc = (f32x4){0.f, 0.f, 0.f, 0.f};
#pragma unroll
                for (int ks = 0; ks < 4; ++ks) acc = __builtin_amdgcn_mfma_f32_16x16x32_bf16(Af[ks], st.Qf[g][ks], acc, 0, 0, 0);
                sa[kk][m2][g] = acc; }
        }
    __builtin_amdgcn_sched_barrier(0);
#pragma unroll
    for (int g = 0; g < 2; ++g) {
        const bool mysel = (st.mymask[g] >> n) & 1u;
        const float kc = mysel ? st.b128 - st.mrun[g] : -INFINITY;
#pragma unroll
        for (int kk = 0; kk < 2; ++kk)
#pragma unroll
            for (int m2 = 0; m2 < 2; ++m2) {
                const int mt = 2 * kk + m2; f32x4 acc = sa[kk][m2][g];
                if (FAR) {
                    float e[4];
#pragma unroll
                    for (int j = 0; j < 4; ++j) e[j] = acc[j] * c2 + kc;
                    tsh[g] = __builtin_fmaxf(__builtin_fmaxf(tsh[g], __builtin_fmaxf(e[0], e[1])), __builtin_fmaxf(e[2], e[3]));
#pragma unroll
                    for (int j = 0; j < 4; ++j) { e[j] = __builtin_amdgcn_exp2f(e[j]); acc[j] = e[j]; }
                    ps[g] += (e[0] + e[1]) + (e[2] + e[3]);
                } else {
                    float bv[4]; bool okv[4];
#pragma unroll
                    for (int j = 0; j < 4; ++j) { const int s = s0 + 16 * mt + 4 * fq + j; int d = st.tq[g] - s; okv[j] = past ? mysel : (d >= 0);
                        d = d < 0 ? 0 : (d > 128 ? 128 : d); bv[j] = btl[d]; }
#pragma unroll
                    for (int j = 0; j < 4; ++j) { const float vv = acc[j] * c2 + bv[j]; const float v = okv[j] ? vv : -INFINITY; tmax[g] = fmaxf(tmax[g], v);
                        const float e = __builtin_amdgcn_exp2f(v - st.mrun[g]); acc[j] = e; ps[g] += e; }
                }
                sa[kk][m2][g] = acc; }
    }
#pragma unroll
    for (int kk = 0; kk < 2; ++kk)
#pragma unroll
        for (int g = 0; g < 2; ++g) { const f32x4 p0 = sa[kk][0][g], p1 = sa[kk][1][g];
            u32x4 pw; pw.x = pk2(p0[0], p0[1]); pw.y = pk2(p0[2], p0[3]); pw.z = pk2(p1[0], p1[1]); pw.w = pk2(p1[2], p1[3]);
            Pf[g][kk] = __builtin_bit_cast(bf16x8, pw); }
    __builtin_amdgcn_sched_barrier(0);
}
template <int S>
HK_DI void moba_step(HK_LAS unsigned char* lds, const HK_LAS int* tl, const HK_LAS float* btl, MobaSt& st, const int i) {
    const int fr = st.fr, fq = st.fq;
    if ((S & 1) == 0) {
        asm volatile("s_waitcnt vmcnt(0)" ::: "memory");
        __builtin_amdgcn_s_barrier();
        asm volatile("" ::: "memory");
        if (i + 2 < st.ntile) {
#pragma unroll
            for (int u = 0; u < 2; ++u) {
                const int s0n = tl[1 + i + 2 + u]; HK_LAS unsigned char* stn = lds + ((S + 2 + u) & 3) * 32768 + st.wave1024;
                __builtin_amdgcn_global_load_lds((const unsigned*)(st.ksrc[0] + (size_t)s0n * NP), (HK_LAS unsigned*)(stn), 16, 0, 0);
                __builtin_amdgcn_global_load_lds((const unsigned*)(st.ksrc[1] + (size_t)s0n * NP), (HK_LAS unsigned*)(stn + 8192), 16, 0, 0);
                __builtin_amdgcn_global_load_lds((const unsigned*)(st.vsrc[0] + s0n), (HK_LAS unsigned*)(stn + 16384), 16, 0, 0);
                __builtin_amdgcn_global_load_lds((const unsigned*)(st.vsrc[1] + s0n), (HK_LAS unsigned*)(stn + 16384 + 8192), 16, 0, 0);
            }
        }
    }
    const int s0 = __builtin_amdgcn_readfirstlane(tl[1 + i]);
    const int n = s0 >> 8; const bool past = n < st.own;
    if (!past && (s0 & 255) > st.wave32 + 31) return;
    const HK_LAS unsigned char* kst = lds + S * 32768; const HK_LAS unsigned char* vst = kst + 16384;
    float tmax[2] = {-INFINITY, -INFINITY}, ps[2] = {0.f, 0.f}, tsh[2] = {-INFINITY, -INFINITY};
    const bool far = past && (st.tq0 - (s0 + 63) >= 128);
    const float c2 = ATTN_SCALE * 1.4426950408889634f;
    bf16x8 Pf[2][2];
    if (far) moba_scores<S, true>(kst, btl, st, s0, n, past, c2, tmax, ps, tsh, Pf);
    else moba_scores<S, false>(kst, btl, st, s0, n, past, c2, tmax, ps, tsh, Pf);
#pragma unroll
    for (int kk = 0; kk < 2; ++kk) {
        bf16x8 Vf[8];
#pragma unroll
        for (int md = 0; md < 8; ++md) Vf[md] = *(const HK_LAS bf16x8*)(vst + (16 * md + fr) * 128 + 16 * ((4 * kk + fq) ^ (fr >> 1)));
#pragma unroll
        for (int md = 0; md < 8; ++md) {
            st.o[0][md] = __builtin_amdgcn_mfma_f32_16x16x32_bf16(Vf[md], Pf[0][kk], st.o[0][md], 0, 0, 0);
            st.o[1][md] = __builtin_amdgcn_mfma_f32_16x16x32_bf16(Vf[md], Pf[1][kk], st.o[1][md], 0, 0, 0);
        }
    }
#pragma unroll
    for (int g = 0; g < 2; ++g) {
        st.lrun[g] += ps[g];
        const float tm = rows_max(fmaxf(tmax[g], tsh[g] + st.mrun[g]));
        const bool need = tm > st.mrun[g] + 8.0f;
        if (__ballot(need) != 0ull) {
            const float alpha = need ? __builtin_amdgcn_exp2f(st.mrun[g] - tm) : 1.0f;
            st.mrun[g] = need ? tm : st.mrun[g];
            st.lrun[g] *= alpha;
#pragma unroll
            for (int i2 = 0; i2 < 8; ++i2) st.o[g][i2] *= alpha;
        }
    }
}
HK_DI void phase4_moba(HK_LAS unsigned char* lds, const Args& a) {
    const int tid = threadIdx.x, lane = tid & 63, wave = __builtin_amdgcn_readfirstlane(tid >> 6), fr = lane & 15, fq = lane >> 4;
    unsigned char* ws = a.ws;
    const bf16_t* PROJ = (const bf16_t*)(ws + WS_PROJ); const bf16_t* VT = (const bf16_t*)(ws + WS_VT); const float* KM = (const float*)(ws + WS_KMEAN);
    const float* BT = (const float*)(ws + WS_BT); bf16_t* Y = (bf16_t*)(ws + WS_H);
    HK_LAS float* gates = (HK_LAS float*)lds;
    HK_LAS unsigned* selm = (HK_LAS unsigned*)(lds + 131072);
    HK_LAS int* tl = (HK_LAS int*)(lds + 131072 + 1040);
    HK_LAS float* btl = (HK_LAS float*)(lds + 131072 + 1040 + 336);
    const bool xmap = (gridDim.x == 256);
    for (int it0 = blockIdx.x, rr = 0; it0 < 1024; it0 += gridDim.x, ++rr) {
        int bh, qt;
        if (xmap) { const int lb = blockIdx.x >> 3; bh = (blockIdx.x & 7) + 8 * (2 * rr + (lb >> 4)); qt = (rr & 1) ? 15 - (lb & 15) : (lb & 15); }
        else { bh = it0 & 63; qt = it0 >> 6; }
        const int h = bh & 15, b = bh >> 4, own = qt, t0 = qt * 256;
        const size_t tok0 = (size_t)b * 4096 + t0;
        __syncthreads();
        MobaSt st;
#pragma unroll
        for (int g = 0; g < 2; ++g) { const int ql = 32 * wave + 16 * g + fr; st.tq[g] = t0 + ql;
            const bf16_t* qp = PROJ + (tok0 + ql) * NP + QB_OFF + h * 128 + 8 * fq;
#pragma unroll
            for (int ks = 0; ks < 4; ++ks) st.Qf[g][ks] = *(const bf16x8*)(qp + 32 * ks); }
        { const float* kmr = KM + ((size_t)(b * 16 + fr) * 16 + h) * 128 + 8 * fq;
          bf16x8 Khi[4], Klo[4];
#pragma unroll
          for (int ks = 0; ks < 4; ++ks) { const float4 f0 = *(const float4*)(kmr + 32 * ks), f1 = *(const float4*)(kmr + 32 * ks + 4);
              u32x4 hi, lo; hi.x = pk2(f0.x, f0.y); hi.y = pk2(f0.z, f0.w); hi.z = pk2(f1.x, f1.y); hi.w = pk2(f1.z, f1.w);
              lo.x = pk2(f0.x - bflo(hi.x), f0.y - bfhi(hi.x)); lo.y = pk2(f0.z - bflo(hi.y), f0.w - bfhi(hi.y)); lo.z = pk2(f1.x - bflo(hi.z), f1.y - bfhi(hi.z)); lo.w = pk2(f1.z - bflo(hi.w), f1.w - bfhi(hi.w));
              Khi[ks] = __builtin_bit_cast(bf16x8, hi); Klo[ks] = __builtin_bit_cast(bf16x8, lo); }
#pragma unroll
          for (int g = 0; g < 2; ++g) { f32x4 acc = (f32x4){0.f, 0.f, 0.f, 0.f};
#pragma unroll
              for (int ks = 0; ks < 4; ++ks) { acc = __builtin_amdgcn_mfma_f32_16x16x32_bf16(Khi[ks], st.Qf[g][ks], acc, 0, 0, 0); acc = __builtin_amdgcn_mfma_f32_16x16x32_bf16(Klo[ks], st.Qf[g][ks], acc, 0, 0, 0); }
              *(HK_LAS f32x4*)(gates + (32 * wave + 16 * g + fr) * 16 + 4 * fq) = acc; }
          if (tid == 0) selm[256] = 0u;
          if (tid < 129) { int ti = tid; asm volatile("" : "+v"(ti));
              btl[ti] = BT[(16 + h) * BT_PITCH + ti] * 1.4426950408889634f; } }
        __syncthreads();
        if (tid < 256) {
            float gv[16];
#pragma unroll
            for (int i = 0; i < 4; ++i) { const f32x4 g4 = *(const HK_LAS f32x4*)(gates + tid * 16 + 4 * i); gv[4 * i] = g4[0]; gv[4 * i + 1] = g4[1]; gv[4 * i + 2] = g4[2]; gv[4 * i + 3] = g4[3]; }
            unsigned m = 0u;
#pragma unroll
            for (int r = 0; r < 3; ++r) if (r < own) { float best = -INFINITY; int bi = -1;
#pragma unroll
                for (int n = 0; n < 15; ++n) { const bool free_ = (n < own) && !((m >> n) & 1u); if (free_ && (bi < 0 || gv[n] > best)) { best = gv[n]; bi = n; } }
                if (bi >= 0) m |= 1u << bi; }
            selm[tid] = m; __hip_atomic_fetch_or(&selm[256], m, __ATOMIC_RELAXED, __HIP_MEMORY_SCOPE_WORKGROUP);
        }
        __syncthreads();
        if (tid == 0) { const unsigned um = selm[256]; int c = 0;
            for (int n = 0; n <= own; ++n) if (n == own || ((um >> n) & 1u)) { tl[1 + c] = 256 * n; tl[2 + c] = 256 * n + 64; tl[3 + c] = 256 * n + 128; tl[4 + c] = 256 * n + 192; c += 4; }
            tl[0] = c; }
        __syncthreads();
        st.ntile = __builtin_amdgcn_readfirstlane(tl[0]); st.own = own; st.wave1024 = (wave & 7) * 1024; st.fr = fr; st.fq = fq; st.wave32 = 32 * wave; st.tq0 = t0 + 32 * wave; st.b128 = btl[128];
#pragma unroll
        for (int g = 0; g < 2; ++g) st.mymask[g] = selm[32 * wave + 16 * g + fr];
#pragma unroll
        for (int g = 0; g < 2; ++g) {
#pragma unroll
            for (int i = 0; i < 8; ++i) st.o[g][i] = (f32x4){0.f, 0.f, 0.f, 0.f};
            st.mrun[g] = 0.f; st.lrun[g] = 0.f; }
#pragma unroll
        for (int i = 0; i < 2; ++i) { const int c = tid + 512 * i;
            { const int r = c >> 4, p = c & 15; st.ksrc[i] = PROJ + ((size_t)b * 4096 + r) * NP + KB_OFF + h * 128 + 8 * (p ^ (r & 15)); }
            { const int d = c >> 3, p = c & 7; st.vsrc[i] = VT + ((size_t)bh * 128 + d) * 4096 + 8 * (p ^ ((d >> 1) & 7)); } }
        asm volatile("s_waitcnt vmcnt(0)" ::: "memory");
        __syncthreads();
#pragma unroll
        for (int j = 0; j < 2; ++j) { const int s0_ = tl[1 + j]; HK_LAS unsigned char* st_ = lds + j * 32768 + st.wave1024;
            __builtin_amdgcn_global_load_lds((const unsigned*)(st.ksrc[0] + (size_t)s0_ * NP), (HK_LAS unsigned*)(st_), 16, 0, 0);
            __builtin_amdgcn_global_load_lds((const unsigned*)(st.ksrc[1] + (size_t)s0_ * NP), (HK_LAS unsigned*)(st_ + 8192), 16, 0, 0);
            __builtin_amdgcn_global_load_lds((const unsigned*)(st.vsrc[0] + s0_), (HK_LAS unsigned*)(st_ + 16384), 16, 0, 0);
            __builtin_amdgcn_global_load_lds((const unsigned*)(st.vsrc[1] + s0_), (HK_LAS unsigned*)(st_ + 16384 + 8192), 16, 0, 0); }
        for (int i0 = 0; i0 < st.ntile; i0 += 4) {
            moba_step<0>(lds, tl, btl, st, i0); moba_step<1>(lds, tl, btl, st, i0 + 1); moba_step<2>(lds, tl, btl, st, i0 + 2); moba_step<3>(lds, tl, btl, st, i0 + 3);
        }
#pragma unroll
        for (int g = 0; g < 2; ++g) {
            const float l = rows_sum(st.lrun[g]);
            const float inv = 1.0f / l;
            const size_t tok = tok0 + 32 * wave + 16 * g + fr;
#pragma unroll
            for (int md = 0; md < 8; ++md) { const int col = h * 128 + 16 * md + 4 * fq;
                const u32x2 gz = *(const u32x2*)(PROJ + tok * NP + Z_OFF + 2048 + col);
                u32x2 w; w.x = pk2(st.o[g][md][0] * inv * bflo(gz.x), st.o[g][md][1] * inv * bfhi(gz.x)); w.y = pk2(st.o[g][md][2] * inv * bflo(gz.y), st.o[g][md][3] * inv * bfhi(gz.y));
                *(u32x2*)(Y + tok * DM + 2048 + col) = w; }
        }
    }
    __syncthreads();
}

HK_DI void phase9_conv(const Args& a) {
    unsigned char* ws = a.ws;
    const bf16_t* XRZ = (const bf16_t*)(ws + WS_XRZ); bf16_t* XC = (bf16_t*)(ws + WS_XC);
    const float* cw = a.in[12]; const float* cbias = a.in[13];
    const size_t gtid = (size_t)blockIdx.x * NTHREADS + threadIdx.x, gstride = (size_t)gridDim.x * NTHREADS;
    if (gtid < 256) ((unsigned*)(XC + (size_t)NTOK * DRNN))[gtid] = 0u;
    for (size_t i = gtid; i < (size_t)(NTOK / 16) * 640; i += gstride) {
        const int cg = (int)(i % 640), rc = (int)(i / 640), c0 = cg * 8, row0 = rc * 16, tin = row0 & 4095;
        float w[4][8], bb[8];
#pragma unroll
        for (int j = 0; j < 4; ++j) { const float4 u0 = *(const float4*)(cw + j * DRNN + c0), u1 = *(const float4*)(cw + j * DRNN + c0 + 4);
            w[j][0] = u0.x; w[j][1] = u0.y; w[j][2] = u0.z; w[j][3] = u0.w; w[j][4] = u1.x; w[j][5] = u1.y; w[j][6] = u1.z; w[j][7] = u1.w; }
        { const float4 u0 = *(const float4*)(cbias + c0), u1 = *(const float4*)(cbias + c0 + 4);
          bb[0] = u0.x; bb[1] = u0.y; bb[2] = u0.z; bb[3] = u0.w; bb[4] = u1.x; bb[5] = u1.y; bb[6] = u1.z; bb[7] = u1.w; }
        float x0[8], x1[8], x2[8];
#pragma unroll
        for (int e = 0; e < 8; ++e) { x0[e] = 0.f; x1[e] = 0.f; x2[e] = 0.f; }
        if (tin >= 3) {
            const u32x4 r0 = *(const u32x4*)(XRZ + (size_t)(row0 - 3) * NP2 + c0), r1 = *(const u32x4*)(XRZ + (size_t)(row0 - 2) * NP2 + c0), r2 = *(const u32x4*)(XRZ + (size_t)(row0 - 1) * NP2 + c0);
            x0[0] = bflo(r0.x); x0[1] = bfhi(r0.x); x0[2] = bflo(r0.y); x0[3] = bfhi(r0.y); x0[4] = bflo(r0.z); x0[5] = bfhi(r0.z); x0[6] = bflo(r0.w); x0[7] = bfhi(r0.w);
            x1[0] = bflo(r1.x); x1[1] = bfhi(r1.x); x1[2] = bflo(r1.y); x1[3] = bfhi(r1.y); x1[4] = bflo(r1.z); x1[5] = bfhi(r1.z); x1[6] = bflo(r1.w); x1[7] = bfhi(r1.w);
            x2[0] = bflo(r2.x); x2[1] = bfhi(r2.x); x2[2] = bflo(r2.y); x2[3] = bfhi(r2.y); x2[4] = bflo(r2.z); x2[5] = bfhi(r2.z); x2[6] = bflo(r2.w); x2[7] = bfhi(r2.w);
        }
#pragma unroll
        for (int r = 0; r < 16; ++r) {
            const u32x4 rr = *(const u32x4*)(XRZ + (size_t)(row0 + r) * NP2 + c0);
            const float x3[8] = {bflo(rr.x), bfhi(rr.x), bflo(rr.y), bfhi(rr.y), bflo(rr.z), bfhi(rr.z), bflo(rr.w), bfhi(rr.w)};
            float y[8];
#pragma unroll
            for (int e = 0; e < 8; ++e) y[e] = bb[e] + x0[e] * w[0][e] + x1[e] * w[1][e] + x2[e] * w[2][e] + x3[e] * w[3][e];
            u32x4 ow; ow.x = pk2(y[0], y[1]); ow.y = pk2(y[2], y[3]); ow.z = pk2(y[4], y[5]); ow.w = pk2(y[6], y[7]);
            *(u32x4*)(XC + (size_t)(row0 + r) * DRNN + c0) = ow;
#pragma unroll
            for (int e = 0; e < 8; ++e) { x0[e] = x1[e]; x1[e] = x2[e]; x2[e] = x3[e]; }
        }
    }
}

constexpr int SCAN_CH = 128, SCAN_NCH = SEQ / SCAN_CH;
template <int PASS>
HK_DI void phase_scan(const Args& a) {
    unsigned char* ws = a.ws;
    const bf16_t* LA = (const bf16_t*)(ws + WS_XRZ); const bf16_t* BB = (const bf16_t*)(ws + WS_BB); const bf16_t* SZ = (const bf16_t*)(ws + WS_XRZ) + DRNN;
    bf16_t* Y1 = (bf16_t*)(ws + WS_XC);
    float* CP = (float*)(ws + WS_CARRY); float* CH = CP + (size_t)NBATCH * SCAN_NCH * DRNN;
    const size_t gtid = (size_t)blockIdx.x * NTHREADS + threadIdx.x, gstride = (size_t)gridDim.x * NTHREADS;
    for (size_t i = gtid; i < (size_t)NBATCH * SCAN_NCH * (DRNN / 8); i += gstride) {
        const int co = (int)(i % (DRNN / 8)), bc = (int)(i / (DRNN / 8)), ch = bc % SCAN_NCH, b = bc / SCAN_NCH, c = 8 * co;
        const size_t row0 = (size_t)b * SEQ + (size_t)ch * SCAN_CH;
        float h[8], P[8];
#pragma unroll
        for (int e = 0; e < 8; ++e) { h[e] = 0.f; P[e] = 1.f; }
        if (PASS == 2) {
            for (int k = 0; k < ch; ++k) { const float* pp = CP + ((size_t)(b * SCAN_NCH + k)) * DRNN + c; const float* hh = CH + ((size_t)(b * SCAN_NCH + k)) * DRNN + c;
                const float4 p0 = *(const float4*)pp, p1 = *(const float4*)(pp + 4), h0 = *(const float4*)hh, h1 = *(const float4*)(hh + 4);
                h[0] = p0.x * h[0] + h0.x; h[1] = p0.y * h[1] + h0.y; h[2] = p0.z * h[2] + h0.z; h[3] = p0.w * h[3] + h0.w;
                h[4] = p1.x * h[4] + h1.x; h[5] = p1.y * h[5] + h1.y; h[6] = p1.z * h[6] + h1.z; h[7] = p1.w * h[7] + h1.w; }
        }
#pragma unroll 8
        for (int r = 0; r < SCAN_CH; ++r) {
            const u32x4 lw = *(const u32x4*)(LA + (row0 + r) * NP2 + c), bw = *(const u32x4*)(BB + (row0 + r) * DRNN + c);
            const float la[8] = {bflo(lw.x), bfhi(lw.x), bflo(lw.y), bfhi(lw.y), bflo(lw.z), bfhi(lw.z), bflo(lw.w), bfhi(lw.w)};
            const float bv[8] = {bflo(bw.x), bfhi(bw.x), bflo(bw.y), bfhi(bw.y), bflo(bw.z), bfhi(bw.z), bflo(bw.w), bfhi(bw.w)};
#pragma unroll
            for (int e = 0; e < 8; ++e) { const float av = __expf(la[e]); h[e] = av * h[e] + bv[e]; if (PASS == 1) P[e] *= av; }
            if (PASS == 2) { const u32x4 zw = *(const u32x4*)(SZ + (row0 + r) * NP2 + c);
                u32x4 o; o.x = pk2(h[0] * bflo(zw.x), h[1] * bfhi(zw.x)); o.y = pk2(h[2] * bflo(zw.y), h[3] * bfhi(zw.y)); o.z = pk2(h[4] * bflo(zw.z), h[5] * bfhi(zw.z)); o.w = pk2(h[6] * bflo(zw.w), h[7] * bfhi(zw.w));
                *(u32x4*)(Y1 + (row0 + r) * DRNN + c) = o; }
        }
        if (PASS == 1) { float* pp = CP + (size_t)bc * DRNN + c; float* hh = CH + (size_t)bc * DRNN + c;
            *(float4*)pp = make_float4(P[0], P[1], P[2], P[3]); *(float4*)(pp + 4) = make_float4(P[4], P[5], P[6], P[7]);
            *(float4*)hh = make_float4(h[0], h[1], h[2], h[3]); *(float4*)(hh + 4) = make_float4(h[4], h[5], h[6], h[7]); }
    }
}

HK_DI void phase_final_norm(const Args& a) {
    const int tid = threadIdx.x, lane = tid & 63, wave = tid >> 6;
    const float* g = a.in[2];
    const bf16_t* R = (const bf16_t*)(a.ws + WS_H1);
    for (int row = blockIdx.x * 8 + wave; row < NTOK; row += gridDim.x * 8) {
        float4* xr = (float4*)(a.out + (size_t)row * DM); const u32x2* rr = (const u32x2*)(R + (size_t)row * DM);
        const u32x2* x1r = (const u32x2*)(a.out + (size_t)row * DM + DM / 2);
        float4 v[16]; float ss = 0.f;
#pragma unroll
        for (int i = 0; i < 16; ++i) { const u32x2 w1 = x1r[lane + 64 * i]; const u32x2 w = rr[lane + 64 * i];
            v[i].x = bflo(w1.x) + bflo(w.x); v[i].y = bfhi(w1.x) + bfhi(w.x); v[i].z = bflo(w1.y) + bflo(w.y); v[i].w = bfhi(w1.y) + bfhi(w.y);
            ss += v[i].x * v[i].x + v[i].y * v[i].y + v[i].z * v[i].z + v[i].w * v[i].w; }
        ss = wave_sum(ss);
        const float inv = rsqrtf(ss * (1.0f / DM) + EPS);
#pragma unroll
        for (int i = 0; i < 16; ++i) { const float4 gg = ((const float4*)g)[lane + 64 * i];
            xr[lane + 64 * i] = make_float4(v[i].x * inv * gg.x, v[i].y * inv * gg.y, v[i].z * inv * gg.z, v[i].w * inv * gg.w); }
    }
}

}

#ifndef HK_N_LAUNCHES
#define HK_N_LAUNCHES 1
#endif
constexpr int HK_NPHASES = 15;

__global__ void __launch_bounds__(hk::NTHREADS, 2) hk_fwd(hk::Args args) {
    using namespace hk;
    extern __shared__ __attribute__((aligned(16))) unsigned char lds_raw[];
    HK_LAS unsigned char* lds = (HK_LAS unsigned char*)lds_raw;
    const int tid = threadIdx.x;
    unsigned char* ws = args.ws;
    if (tid < 4) ((HK_LAS unsigned*)(lds + LDS_MISC))[tid] = 0u;
    __syncthreads();
    const int lo = args.ph_lo, hi = args.ph_hi;
    XcdBarrier bar; bar.bar = (unsigned*)(ws + WS_CTL) + args.li * XCD_BAR_WORDS; bar.x = 0; bar.st = nullptr;
    if (hi - lo > 1) bar = xcd_barrier_post((unsigned*)(ws + WS_CTL) + args.li * XCD_BAR_WORDS, (volatile LAS unsigned*)(lds + LDS_MISC));
#ifndef HK_PHASE_MASK
#define HK_PHASE_MASK 0x7fff
#endif
#define HK_IN(k) (((HK_PHASE_MASK >> (k)) & 1) && lo <= (k) && (k) < hi)
#define HK_SEAM(k) do { if (HK_IN(k) && HK_IN((k) + 1)) xcd_barrier(bar); } while (0)

    if (HK_IN(0)) { phase0_prologue(lds, args); HK_SEAM(0); }
    if (HK_IN(1)) {
        { const pg8::Gemm g = mk_gemm((const bf16_t*)(ws + WS_H), (const bf16_t*)(ws + WS_WIN_T), NTOK, 32 * 256, DM);
          pg8::StaticOrder S; S.init(NTOK, 32 * 256, (int)gridDim.x, (int)blockIdx.x);
          EpiBf16Silu E{(bf16_t*)(ws + WS_PROJ), NP, Z_OFF / 256, Z_OFF / 256 + 16, 0};
          pg8::gemm_phase<EpiBf16Silu, pg8::StaticOrder, false>(lds, g, S, E, nullptr); }
        { const pg8::Gemm g = mk_gemm((const bf16_t*)(ws + WS_H), (const bf16_t*)(ws + WS_WIN_T) + (size_t)32 * 256 * DM, NTOK, 27 * 256, DM);
          pg8::StaticOrder S; S.init(NTOK, 27 * 256, (int)gridDim.x, (int)blockIdx.x);
          EpiBf16Silu E{(bf16_t*)(ws + WS_PROJ), NP, Z_OFF / 256, Z_OFF / 256 + 16, 32};
          pg8::gemm_phase<EpiBf16Silu, pg8::StaticOrder, false>(lds, g, S, E, nullptr); }
        HK_SEAM(1);
    }
    if (HK_IN(2)) { phase2_post(lds, args); HK_SEAM(2); }
    if (HK_IN(3)) {
        phase3_indexer(lds, args); __syncthreads();
        {
            const pg8::Gemm g = mk_gemm_b((const bf16_t*)(ws + WS_PROJ) + QA_OFF, (const bf16_t*)(ws + WS_WUK), NTOK, 512, 128, NP, 256, (size_t)128, (size_t)512 * 256, 16);
            pg8::StaticOrder S; S.init(NTOK, 512, (int)gridDim.x, (int)blockIdx.x, 16);
            EpiQlatP E{(bf16_t*)args.out};
            pg8::gemm_phase<EpiQlatP, pg8::StaticOrder, false>(lds, g, S, E, nullptr);
        }
        HK_SEAM(3);
    }
    if (HK_IN(4)) { if (!(args.pad & 1)) { phase4_dsa(lds, args); __syncthreads(); } if (!(args.pad & 2)) phase4_moba(lds, args); HK_SEAM(4); }
    if (HK_IN(5)) {
        const pg8::Gemm g = mk_gemm_b((const bf16_t*)args.out, (const bf16_t*)(ws + WS_WUVT), NTOK, 256, 512, 8192, 512, (size_t)512, (size_t)256 * 512, 16);
        pg8::StaticOrder S; S.init(NTOK, 256, (int)gridDim.x, (int)blockIdx.x, 16);
        EpiOaP E{(bf16_t*)(ws + WS_H), (const bf16_t*)(ws + WS_PROJ)};
        pg8::gemm_phase<EpiOaP, pg8::StaticOrder, false>(lds, g, S, E, nullptr);
        HK_SEAM(5);
    }
    if (HK_IN(6)) {
        const pg8::Gemm g = mk_gemm((const bf16_t*)(ws + WS_H), (const bf16_t*)(ws + WS_WOUT_T), NTOK, DM, DM);
        pg8::StaticOrder S; S.init(NTOK, DM, (int)gridDim.x, (int)blockIdx.x);
        EpiResidStats E{(bf16_t*)args.out + DM, 2 * DM, args.in[0], DM, (float*)(ws + WS_VT)};
        pg8::gemm_phase<EpiResidStats, pg8::StaticOrder, false>(lds, g, S, E, nullptr);
        HK_SEAM(6);
    }
    if (HK_IN(8)) {
        pg8::StaticOrder S; S.init(NTOK, NP2, (int)gridDim.x, (int)blockIdx.x);
        HK_LAS float* rs = (HK_LAS float*)(lds + 131072);
        { int pm0;
          { const int nwg = S.nM * S.nN, wg0 = (int)blockIdx.x % nwg; const int q = nwg / pg8::NXCD, rr = nwg % pg8::NXCD, xcd = wg0 % pg8::NXCD, off = wg0 / pg8::NXCD;
            const int wg = (xcd < rr ? xcd * (q + 1) : rr * (q + 1) + (xcd - rr) * q) + off; const int nig = pg8::WGM * S.nN, fm = (wg / nig) * pg8::WGM, gsz = (S.nM - fm) < pg8::WGM ? (S.nM - fm) : pg8::WGM;
            pm0 = fm + ((wg % nig) % gsz); }
          const int r = tid >> 1, hh = tid & 1; const float4* sp = (const float4*)((const float*)(ws + WS_VT) + (size_t)(pm0 * 256 + r) * 64 + 32 * hh);
          float ssum = 0.f;
#pragma unroll
          for (int i = 0; i < 8; ++i) { const float4 v = sp[i]; ssum += (v.x + v.y) + (v.z + v.w); }
          ssum += __shfl_xor(ssum, 1);
          if (hh == 0) rs[r] = rsqrtf(ssum * (1.0f / DM) + EPS);
          __syncthreads(); }
        const pg8::Gemm g = mk_gemm_b((const bf16_t*)args.out + DM, (const bf16_t*)(ws + WS_RWIN_T), NTOK, NP2, DM, 2 * DM, DM, (size_t)0, (size_t)0, 1);
        EpiBf16SiluRow E{(bf16_t*)(ws + WS_XRZ), NP2, DRNN / 256, NP2 / 256, rs};
        pg8::gemm_phase<EpiBf16SiluRow, pg8::StaticOrder, false>(lds, g, S, E, nullptr);
        HK_SEAM(8);
    }
    if (HK_IN(9)) { phase9_conv(args); HK_SEAM(9); }
    if (HK_IN(10)) {
        const pg8::Gemm g = mk_gemm_b((const bf16_t*)(ws + WS_XC), (const bf16_t*)(ws + WS_WG_T), NTOK, 768, 384, DRNN, 384, (size_t)320, (size_t)768 * 384, 16);
        pg8::StaticOrder S; S.init(NTOK, 768, (int)gridDim.x, (int)blockIdx.x, 16);
        EpiGateP E{(bf16_t*)(ws + WS_XRZ), (bf16_t*)(ws + WS_BB), (const bf16_t*)(ws + WS_XC), args.in[15], args.in[17], (const float*)(ws + WS_LC)};
        pg8::gemm_phase<EpiGateP, pg8::StaticOrder, false>(lds, g, S, E, nullptr);
        HK_SEAM(10);
    }
    if (HK_IN(11)) { phase_scan<1>(args); HK_SEAM(11); }
    if (HK_IN(12)) { phase_scan<2>(args); HK_SEAM(12); }
    if (HK_IN(13)) {
        const pg8::Gemm g = mk_gemm((const bf16_t*)(ws + WS_XC), (const bf16_t*)(ws + WS_RWOUT_T), NTOK, DM, DRNN);
        pg8::StaticOrder S; S.init(NTOK, DM, (int)gridDim.x, (int)blockIdx.x);
        EpiBf16Silu E{(bf16_t*)(ws + WS_H1), DM, 0, 0, 0};
        pg8::gemm_phase<EpiBf16Silu, pg8::StaticOrder, false>(lds, g, S, E, nullptr);
        HK_SEAM(13);
    }
    if (HK_IN(14)) { phase_final_norm(args); }
#undef HK_IN
#undef HK_SEAM
}

extern "C" void kernel_launch(void* const* d_in, const int* in_sizes, int n_in, void* d_out, int out_size, void* d_ws, size_t ws_size, hipStream_t stream) {
    static int grid = 0;
    if (grid == 0) {
        if (n_in != 20 || out_size != hk::NTOK * hk::DM || ws_size < hk::WS_NEED) {
            fprintf(stderr, "kernel_launch: unexpected problem (n_in %d, out %d, ws %zu, need %zu); nothing launched\n", n_in, out_size, ws_size, (size_t)hk::WS_NEED); grid = -1; return; }
        int dev = 0, cus = 0, per_cu = 0;
        if (hipGetDevice(&dev) != hipSuccess || hipDeviceGetAttribute(&cus, hipDeviceAttributeMultiprocessorCount, dev) != hipSuccess) { grid = -1; return; }
        if (hipFuncSetAttribute((const void*)hk_fwd, hipFuncAttributeMaxDynamicSharedMemorySize, hk::LDS_BYTES) != hipSuccess) { fprintf(stderr, "kernel_launch: hipFuncSetAttribute failed\n"); grid = -1; return; }
        if (hipOccupancyMaxActiveBlocksPerMultiprocessor(&per_cu, (const void*)hk_fwd, hk::NTHREADS, hk::LDS_BYTES) != hipSuccess || per_cu < 1)
            fprintf(stderr, "kernel_launch: occupancy query reports %d blocks per CU\n", per_cu);
        (void)hipGetLastError();
        grid = cus >= 64 ? cus - cus % 64 : cus;
    }
    if (grid < 0) return;
    if (hipMemsetAsync((char*)d_ws + hk::WS_CTL, 0, 256 * 1024, stream) != hipSuccess) { fprintf(stderr, "kernel_launch: memset failed\n"); return; }
    hk::Args a{};
    for (int i = 0; i < 20; ++i) a.in[i] = (const float*)d_in[i];
    a.out = (float*)d_out; a.ws = (unsigned char*)d_ws;
#if HK_N_LAUNCHES == 1
#ifdef HK_PROBE_MASK
#ifndef HK_PROBE_P4
#define HK_PROBE_P4 1
#endif
#ifndef HK_PROBE_P3
#define HK_PROBE_P3 0
#endif
#ifndef HK_PROBE_P10
#define HK_PROBE_P10 0
#endif
#ifndef HK_PROBE_REP
#define HK_PROBE_REP 1
#endif
    { int seg_lo = 0;
      for (int k = 0; k < HK_NPHASES; ++k) if ((HK_PROBE_MASK >> k) & 1) {
          a.ph_lo = seg_lo; a.ph_hi = k + 1; hipLaunchKernelGGL(hk_fwd, dim3(grid), dim3(hk::NTHREADS), hk::LDS_BYTES, stream, a); a.li++;
          a.ph_lo = k; a.ph_hi = k + 1; a.pad = (k == 4) ? HK_PROBE_P4 : (k == 3) ? HK_PROBE_P3 : (k == 10) ? HK_PROBE_P10 : 0; for (int r_ = 0; r_ < HK_PROBE_REP; ++r_) hipLaunchKernelGGL(hk_fwd, dim3(grid), dim3(hk::NTHREADS), hk::LDS_BYTES, stream, a); a.pad = 0;
          seg_lo = k + 1; }
      if (seg_lo < HK_NPHASES) { a.ph_lo = seg_lo; a.ph_hi = HK_NPHASES; hipLaunchKernelGGL(hk_fwd, dim3(grid), dim3(hk::NTHREADS), hk::LDS_BYTES, stream, a); } }
#else
    a.ph_lo = 0; a.ph_hi = HK_NPHASES;
    hipLaunchKernelGGL(hk_fwd, dim3(grid), dim3(hk::NTHREADS), hk::LDS_BYTES, stream, a);
#endif
#else
    for (int p = 0; p < HK_NPHASES; ++p) { a.ph_lo = p; a.ph_hi = p + 1; hipLaunchKernelGGL(hk_fwd, dim3(grid), dim3(hk::NTHREADS), hk::LDS_BYTES, stream, a); }
#endif
    const hipError_t le = hipPeekAtLastError();
    if (le != hipSuccess) fprintf(stderr, "kernel_launch: launch failed: %s\n", hipGetErrorName(le));
}
```
